# Optimizing an MI355X kernel written in HIP

```python
import jax
import jax.numpy as jnp
from jax import lax
import numpy as np

D_MODEL = 1024
BATCH = 4
SEQ = 4096
DEPTH = 4

GRID_W = 64
CTX_LEN = 256
HEAD_DIM = 64
EPS = 1e-6
MASK_VALUE = -1e30
ROPE_THETA = 10000.0
N_MOD = 9
D_FF = 256 * ((8 * D_MODEL // 3 + 255) // 256)
HG_WIDTH = D_MODEL // 4
HG_DK = 64
HG_HEADS = HG_WIDTH // HG_DK
HG_DV = HG_WIDTH // HG_HEADS
HG_CHUNK = 64
NA_WIDTH = 3 * D_MODEL // 8
NA_HEADS = NA_WIDTH // HEAD_DIM
NA_ROWS = 8
NA_COLS = 16
SW_WIDTH = D_MODEL - HG_WIDTH - NA_WIDTH
SW_HEADS = SW_WIDTH // HEAD_DIM
SW_KV_HEADS = 2
SW_KV_WIDTH = SW_KV_HEADS * HEAD_DIM
SW_WINDOW = 128
SW_BLOCK = 128
MIX_WIDTH = HG_WIDTH + NA_WIDTH + SW_WIDTH
IN_SPLITS = (HG_WIDTH,) * 5 + (NA_WIDTH,) * 3 + (SW_WIDTH, SW_KV_WIDTH, SW_KV_WIDTH)
IN_WIDTH = sum(IN_SPLITS)

kernel_name = 'hybrid_hgrn2_natten_swa_prefix_dit'


def _rms_norm(x, g):
    xf = x.astype(jnp.float32)
    y = xf * lax.rsqrt(jnp.mean(xf * xf, axis=-1, keepdims=True) + EPS)
    return y.astype(x.dtype) * g


def _modulate(x, g, shift, scale):
    return _rms_norm(x, g) * (1 + scale) + shift


def _swiglu(h, w1, w3, w2):
    return (jax.nn.silu(h @ w1) * (h @ w3)) @ w2


def _softmax32(s):
    return jax.nn.softmax(s.astype(jnp.float32), axis=-1)


def _heads(a, n):
    b, t, _ = a.shape
    return a.reshape(b, t, n, -1).transpose(0, 2, 1, 3)


def _merge(a):
    b, h, t, d = a.shape
    return a.transpose(0, 2, 1, 3).reshape(b, t, h * d)


def _split_cols(p):
    return jnp.split(p, [int(s) for s in np.cumsum(IN_SPLITS)[:-1]], axis=-1)


def _axial_rope(x):
    t = x.shape[2]
    pos = jnp.arange(t)
    pos = jnp.stack([pos // GRID_W, pos % GRID_W], axis=-1).astype(jnp.float32)
    nf = HEAD_DIM // 4
    inv = ROPE_THETA ** (-jnp.arange(nf, dtype=jnp.float32) / nf)
    ang = pos[:, :, None] * inv
    cos, sin = jnp.cos(ang), jnp.sin(ang)
    xs = x.astype(jnp.float32).reshape(*x.shape[:-1], 2, 2, nf)
    x1, x2 = xs[..., 0, :], xs[..., 1, :]
    out = jnp.stack([x1 * cos - x2 * sin, x1 * sin + x2 * cos], axis=-2)
    return out.reshape(x.shape).astype(x.dtype)


def _context_attention(q, k, v, sink):
    s = jnp.einsum('bhgqd,bhkd->bhgqk', q, k).astype(jnp.float32) * q.shape[-1] ** -0.5
    n = s.shape[-1]
    if sink is not None:
        s = jnp.concatenate([s, jnp.broadcast_to(sink[None, :, :, None, None], s.shape[:-1] + (1,))], axis=-1)
    p = _softmax32(s)[..., :n].astype(v.dtype)
    return jnp.einsum('bhgqk,bhkd->bhgqd', p, v)


def _hgrn_gates(z, lb):
    z = z.astype(jnp.float32)
    log_f = jnp.log(lb + (1.0 - lb) * jax.nn.sigmoid(z))
    k = (1.0 - lb) * jax.nn.sigmoid(-z)
    return log_f, k


def _gla_chunk_scan(q, k, v, log_f, s0, with_output):
    b, h, t, _ = q.shape
    n = t // HG_CHUNK

    def blocks(a):
        return jnp.moveaxis(a.reshape(b, h, n, HG_CHUNK, a.shape[-1]), 2, 0)

    lower = jnp.tril(jnp.ones((HG_CHUNK, HG_CHUNK), bool))

    def step(s, inp):
        qc, kc, vc, gc = inp
        cum = jnp.cumsum(gc, axis=2)
        last = cum[:, :, -1]
        s_new = jnp.exp(last)[..., None] * s + jnp.einsum('bhsk,bhsv->bhkv', kc * jnp.exp(last[:, :, None] - cum), vc)
        if not with_output:
            return s_new, None
        o_inter = jnp.einsum('bhtk,bhkv->bhtv', qc * jnp.exp(cum), s)
        rel = jnp.where(lower[:, :, None], cum[:, :, :, None, :] - cum[:, :, None, :, :], MASK_VALUE)
        a = jnp.einsum('bhtk,bhtsk,bhsk->bhts', qc, jnp.exp(rel), kc)
        return s_new, o_inter + jnp.einsum('bhts,bhsv->bhtv', a, vc)

    s, o = lax.scan(step, s0, (blocks(q), blocks(k), blocks(v), blocks(log_f)))
    if with_output:
        o = jnp.moveaxis(o, 0, 2).reshape(b, h, t, -1)
    return s, o


def _hgrn_readout(o, g, norm_g):
    o = o * lax.rsqrt(jnp.mean(o * o, axis=-1, keepdims=True) + EPS)
    o = _merge(o) * norm_g.astype(jnp.float32)
    return (o * jax.nn.silu(g.astype(jnp.float32))).astype(g.dtype)


def _hgrn2_mixer(lat, ctx, lb, norm_g, need_ctx):
    def prep(parts):
        q, z_f, z_b, i, g = parts
        lf_f, k_f = _hgrn_gates(z_f, lb[0])
        lf_b, k_b = _hgrn_gates(z_b, lb[1])
        hd = lambda a: _heads(a, HG_HEADS)
        return (hd(jax.nn.silu(q.astype(jnp.float32))), hd(i.astype(jnp.float32)),
                hd(lf_f), hd(k_f), hd(lf_b), hd(k_b), g)

    def flip(a):
        return a[:, :, ::-1]

    def bidir(parts, s_f, s_b, with_output):
        q, v, lf_f, k_f, lf_b, k_b, g = prep(parts)
        s_f, o_f = _gla_chunk_scan(q, k_f, v, lf_f, s_f, with_output)
        s_b, o_b = _gla_chunk_scan(flip(q), flip(k_b), flip(v), flip(lf_b), s_b, with_output)
        out = _hgrn_readout(o_f + flip(o_b), g, norm_g) if with_output else None
        return s_f, s_b, out

    s0 = jnp.zeros((lat[0].shape[0], HG_HEADS, HG_DK, HG_DV), jnp.float32)
    s_f, s_b, out_ctx = bidir(ctx, s0, s0, need_ctx)
    _, _, out_lat = bidir(lat, s_f, s_b, True)
    return out_lat, out_ctx


def _neighbourhood_attention(q, k, v, qc, kc, vc, rpb, need_ctx):
    b, h, t, dh = q.shape
    rows = t // GRID_W
    wr = min(NA_ROWS, rows)
    n_keys = wr * GRID_W
    scale = dh ** -0.5
    r = jnp.arange(rows)
    row_idx = jnp.clip(r - wr // 2, 0, rows - wr)[:, None] + jnp.arange(wr)[None, :]

    def gather_rows(a):
        return a.reshape(b, h, rows, GRID_W, dh)[:, :, row_idx].reshape(b, h, rows, n_keys, dh)

    kg, vg = gather_rows(k), gather_rows(v)
    qg = q.reshape(b, h, rows, GRID_W, dh)
    col = jnp.arange(GRID_W)
    c0 = jnp.clip(col - NA_COLS // 2, 0, GRID_W - NA_COLS)
    col_ok = (col[None, :] >= c0[:, None]) & (col[None, :] < c0[:, None] + NA_COLS)
    d_row = row_idx - r[:, None]
    d_col = jnp.clip(col[None, :] - col[:, None], 1 - NA_COLS, NA_COLS - 1)
    bias = rpb[:, d_row[:, None, :, None] + NA_ROWS - 1, d_col[None, :, None, :] + NA_COLS - 1].astype(jnp.float32)
    bias = jnp.where(col_ok[None, None, :, None, :], bias, MASK_VALUE).reshape(h, rows, GRID_W, n_keys)
    s_lat = jnp.einsum('bhrqd,bhrkd->bhrqk', qg, kg).astype(jnp.float32) * scale + bias
    s_ctx = jnp.einsum('bhrqd,bhld->bhrql', qg, kc).astype(jnp.float32) * scale
    p = _softmax32(jnp.concatenate([s_lat, s_ctx], axis=-1)).astype(v.dtype)
    o = (jnp.einsum('bhrqk,bhrkd->bhrqd', p[..., :n_keys], vg)
         + jnp.einsum('bhrql,bhld->bhrqd', p[..., n_keys:], vc))
    o = o.reshape(b, h, t, dh)
    oc = _context_attention(qc[:, :, None], kc, vc, None)[:, :, 0] if need_ctx else None
    return o, oc


def _sliding_window_attention(q, k, v, qc, kc, vc, sink, need_ctx):
    b, hq, t, dh = q.shape
    hkv = k.shape[1]
    g = hq // hkv
    n = t // SW_BLOCK
    nk = 3 * SW_BLOCK
    scale = dh ** -0.5
    sink_g = sink.reshape(hkv, g).astype(jnp.float32)
    qb = q.reshape(b, hkv, g, n, SW_BLOCK, dh)

    def band(a):
        ap = jnp.pad(a, ((0, 0), (0, 0), (SW_BLOCK, SW_BLOCK), (0, 0))).reshape(b, hkv, n + 2, SW_BLOCK, dh)
        return jnp.concatenate([ap[:, :, :-2], ap[:, :, 1:-1], ap[:, :, 2:]], axis=3)

    kb, vb = band(k), band(v)
    blk = jnp.arange(n)[:, None]
    q_pos = blk * SW_BLOCK + jnp.arange(SW_BLOCK)[None, :]
    k_pos = (blk - 1) * SW_BLOCK + jnp.arange(nk)[None, :]
    ok = ((jnp.abs(q_pos[:, :, None] - k_pos[:, None, :]) <= SW_WINDOW)
          & (k_pos[:, None, :] >= 0) & (k_pos[:, None, :] < t))
    s_lat = jnp.where(ok, jnp.einsum('bhgnqd,bhnkd->bhgnqk', qb, kb).astype(jnp.float32) * scale, MASK_VALUE)
    s_ctx = jnp.einsum('bhgnqd,bhld->bhgnql', qb, kc).astype(jnp.float32) * scale
    s_sink = jnp.broadcast_to(sink_g[None, :, :, None, None, None], s_ctx.shape[:-1] + (1,))
    p = _softmax32(jnp.concatenate([s_lat, s_ctx, s_sink], axis=-1)).astype(v.dtype)
    n_ctx = kc.shape[2]
    o = (jnp.einsum('bhgnqk,bhnkd->bhgnqd', p[..., :nk], vb)
         + jnp.einsum('bhgnql,bhld->bhgnqd', p[..., nk:nk + n_ctx], vc))
    o = o.reshape(b, hq, t, dh)
    oc = _context_attention(qc.reshape(b, hkv, g, -1, dh), kc, vc, sink_g).reshape(b, hq, -1, dh) if need_ctx else None
    return o, oc


def _mixer_block(hx, hc, w_in, lb, hg_norm_g, rpb, sink, need_ctx):
    px = _split_cols(hx @ w_in)
    pc = _split_cols(hc @ w_in)
    o_hg, oc_hg = _hgrn2_mixer(px[0:5], pc[0:5], lb, hg_norm_g, need_ctx)
    na_lat = [_heads(a, NA_HEADS) for a in px[5:8]]
    na_ctx = [_heads(a, NA_HEADS) for a in pc[5:8]]
    o_na, oc_na = _neighbourhood_attention(*na_lat, *na_ctx, rpb, need_ctx)
    sw_q = _axial_rope(_heads(px[8], SW_HEADS))
    sw_k = _axial_rope(_heads(px[9], SW_KV_HEADS))
    sw_v = _heads(px[10], SW_KV_HEADS)
    o_sw, oc_sw = _sliding_window_attention(sw_q, sw_k, sw_v, _heads(pc[8], SW_HEADS), _heads(pc[9], SW_KV_HEADS),
                                            _heads(pc[10], SW_KV_HEADS), sink, need_ctx)
    out_lat = jnp.concatenate([o_hg, _merge(o_na), _merge(o_sw)], axis=-1)
    out_ctx = jnp.concatenate([oc_hg, _merge(oc_na), _merge(oc_sw)], axis=-1) if need_ctx else None
    return out_lat, out_ctx


def setup_inputs(seed: int = 0) -> dict:
    key = jax.random.key(seed)
    ks = jax.random.split(key, 17)
    f32 = jnp.float32

    def nrm(k, shape, scale):
        return jax.random.normal(k, shape, f32) * scale

    return {
        'x': nrm(ks[0], (BATCH, SEQ, D_MODEL), 1.0),
        'c': nrm(ks[1], (BATCH, D_MODEL), 1.0),
        'ctx': nrm(ks[2], (BATCH, CTX_LEN, D_MODEL), 1.0),
        'c_ctx': nrm(ks[3], (D_MODEL,), 1.0),
        'ada_w': nrm(ks[4], (DEPTH, D_MODEL, N_MOD * D_MODEL), 0.5 * D_MODEL ** -0.5),
        'ada_b': nrm(ks[5], (DEPTH, N_MOD * D_MODEL), 0.02),
        'norm_g': 1.0 + nrm(ks[6], (DEPTH, 3, D_MODEL), 0.02),
        'ffn_w1': nrm(ks[7], (DEPTH, 2, D_MODEL, D_FF), D_MODEL ** -0.5),
        'ffn_w3': nrm(ks[8], (DEPTH, 2, D_MODEL, D_FF), D_MODEL ** -0.5),
        'ffn_w2': nrm(ks[9], (DEPTH, 2, D_FF, D_MODEL), D_FF ** -0.5),
        'w_in': nrm(ks[10], (DEPTH, D_MODEL, IN_WIDTH), D_MODEL ** -0.5),
        'w_out': nrm(ks[11], (DEPTH, MIX_WIDTH, D_MODEL), MIX_WIDTH ** -0.5),
        'hg_lb_logits': nrm(ks[12], (DEPTH, 2, HG_WIDTH), 0.5),
        'hg_norm_g': 1.0 + nrm(ks[13], (DEPTH, HG_WIDTH), 0.02),
        'na_rpb': nrm(ks[14], (DEPTH, NA_HEADS, 2 * NA_ROWS - 1, 2 * NA_COLS - 1), 0.1),
        'sw_sink': nrm(ks[15], (DEPTH, SW_HEADS), 0.5),
        'final_g': 1.0 + nrm(ks[16], (D_MODEL,), 0.02),
    }


def reference(x, c, ctx, c_ctx, ada_w, ada_b, norm_g, ffn_w1, ffn_w3, ffn_w2, w_in, w_out,
              hg_lb_logits, hg_norm_g, na_rpb, sw_sink, final_g):
    lb_soft = jax.nn.softmax(hg_lb_logits.astype(jnp.float32), axis=0)
    lower_bounds = jnp.cumsum(lb_soft, axis=0) - lb_soft[0]
    s_c = jax.nn.silu(c)
    s_cc = jax.nn.silu(c_ctx)
    h = ctx
    for l in range(DEPTH):
        need_ctx = l < DEPTH - 1
        m = jnp.split((s_c @ ada_w[l] + ada_b[l])[:, None, :], N_MOD, axis=-1)
        mc = jnp.split(s_cc @ ada_w[l] + ada_b[l], N_MOD, axis=-1)
        x = x + 0.5 * m[2] * _swiglu(_modulate(x, norm_g[l, 0], m[0], m[1]), ffn_w1[l, 0], ffn_w3[l, 0], ffn_w2[l, 0])
        h = h + 0.5 * mc[2] * _swiglu(_modulate(h, norm_g[l, 0], mc[0], mc[1]), ffn_w1[l, 0], ffn_w3[l, 0], ffn_w2[l, 0])
        o_lat, o_ctx = _mixer_block(_modulate(x, norm_g[l, 1], m[3], m[4]), _modulate(h, norm_g[l, 1], mc[3], mc[4]),
                                    w_in[l], lower_bounds[l], hg_norm_g[l], na_rpb[l], sw_sink[l], need_ctx)
        x = x + m[5] * (o_lat @ w_out[l])
        x = x + 0.5 * m[8] * _swiglu(_modulate(x, norm_g[l, 2], m[6], m[7]), ffn_w1[l, 1], ffn_w3[l, 1], ffn_w2[l, 1])
        if need_ctx:
            h = h + mc[5] * (o_ctx @ w_out[l])
            h = h + 0.5 * mc[8] * _swiglu(_modulate(h, norm_g[l, 2], mc[6], mc[7]), ffn_w1[l, 1], ffn_w3[l, 1], ffn_w2[l, 1])
    return _rms_norm(x, final_g)
```

```cpp
#include <hip/hip_runtime.h>
#include <hip/hip_cooperative_groups.h>
#include <cstdio>
#include <cstdint>
namespace cg = cooperative_groups;
#ifndef ONE_LAUNCH
#define ONE_LAUNCH 1
#endif
namespace pg8 {
#define PG8_LAS __attribute__((address_space(3)))
typedef unsigned short bf16_t;
typedef short bf16x8 __attribute__((ext_vector_type(8)));
typedef float f32x4 __attribute__((ext_vector_type(4)));
typedef unsigned u32x4 __attribute__((ext_vector_type(4)));
constexpr int BM = 256, BK = 64, HALF = 128, HTB = HALF * BK * 2  , STAGE_BYTES = 8 * HTB, NXCD = 8, WGM = 8;

__host__ __device__ __forceinline__ int lds_byte(int r, int c) { const int st = (r >> 4) * 2 + (c >> 5), rr = r & 15, cc = c & 31, ob = rr * 64 + cc * 2; return st * 1024 + (ob ^ (((ob >> 9) & 1) << 5)); }
__host__ __device__ __forceinline__ void stage_rc(int b, int& R, int& C) { const int st = b / 1024, sb = b % 1024, swz = sb ^ (((sb >> 9) & 1) << 5); R = (st >> 1) * 16 + swz / 64; C = (st & 1) * 32 + (swz % 64) / 2; }
__host__ __device__ __forceinline__ int perm32(int rho) { const int n = rho >> 4, i = rho & 15; return 8 * (i >> 2) + 4 * n + (i & 3); }

struct Unit { int pm, pn, k0, nt; };
struct Gemm { const bf16_t* A; const bf16_t* Bt; int M, N, K; };

struct StaticOrder {
    int nM, nN, nwg, G, c, ntK, nsplit, ntsplit, nsmall;
    __host__ __device__ void init(int M, int N, int K, int G_, int c_, int ntsplit_ = 0) { nM = M / BM; nN = N / BM; G = G_; c = c_; ntK = K / BK; ntsplit = ntsplit_; nsplit = 0; nsmall = 0;
        if (ntsplit > 0 && nM > 64) { nsplit = (ntK + ntsplit - 1) / ntsplit; nsmall = (nM - 64) * nN * nsplit; nM = 64; } nwg = nM * nN; }
    __host__ __device__ __forceinline__ bool next(int i, Unit& u) const {
        const long L = (long)i * G + c; if (L >= nwg + nsmall) return false;
        const bool small = L >= nwg;
        const int j = small ? (int)L - nwg : 0, dv = nsplit > 0 ? nsplit : 1, tile = j / dv, sp = j - tile * dv;
        const int rem = ntK - sp * ntsplit, s_pm = 64 + tile / nN, s_pn = tile % nN, s_k0 = sp * ntsplit * BK, s_nt = rem < ntsplit ? rem : ntsplit;
        int wgid = small ? 0 : (int)L; { const int q = nwg / NXCD, r = nwg % NXCD, xcd = wgid % NXCD, off = wgid / NXCD; wgid = (xcd < r ? xcd * (q + 1) : r * (q + 1) + (xcd - r) * q) + off; }
        const int nig = WGM * nN, gid = wgid / nig, fm = gid * WGM, gsz = (nM - fm) < WGM ? (nM - fm) : WGM;
        const int f_pm = fm + ((wgid % nig) % gsz), f_pn = (wgid % nig) / gsz;
        Unit r_; r_.pm = small ? s_pm : f_pm; r_.pn = small ? s_pn : f_pn; r_.k0 = small ? s_k0 : 0; r_.nt = small ? s_nt : ntK; u = r_; return true;
    }
    __device__ __forceinline__ void a_ready(const Unit&) const {}
    __device__ __forceinline__ void done(const Unit&) const {}
};

typedef float cvt_f32x2 __attribute__((ext_vector_type(2)));
typedef __bf16 cvt_bf16x2 __attribute__((ext_vector_type(2)));
__device__ __forceinline__ unsigned cvt_pk_bf16(float lo, float hi) { const cvt_f32x2 v = {lo, hi}; const cvt_bf16x2 r = __builtin_convertvector(v, cvt_bf16x2); return __builtin_bit_cast(unsigned, r); }
typedef float f32x2 __attribute__((ext_vector_type(2)));
template <class Epi, class Sched, bool ALIGN_EPI = false, bool SP2 = false>
__device__ __forceinline__ void gemm_phase(PG8_LAS unsigned char* lds, const Gemm g, const Sched& S, const Epi& E) {
    int tid = threadIdx.x; asm volatile("" : "+v"(tid));
    const int wid = __builtin_amdgcn_readfirstlane(tid >> 6), lane = tid & 63, wr = wid >> 2, wc = wid & 3, fr = lane & 15, fq = lane >> 4;
    const int K = g.K;
    unsigned voffA[2], voffB[2];
#pragma unroll
    for (int i = 0; i < 2; ++i) { int R, C; stage_rc(tid * 16 + i * 8192, R, C); const int Rb = Epi::PERM ? ((R & ~31) + perm32(R & 31)) : R;
        voffA[i] = (unsigned)(R * K + C) * 2u; voffB[i] = (unsigned)(Rb * K + C) * 2u; }
    const size_t kstep = (size_t)(BK * 2);
    const size_t hstep = (size_t)HALF * K * 2;
    const size_t tstep = 2 * hstep;
    const unsigned ldsw = (unsigned)wid * 1024u;
    const int aoff = lds_byte(wr * 64 + fr, fq * 8), boff = lds_byte(wc * 32 + fr, fq * 8);
#define PG8_SA(b, h) (((b) * 2 + (h)) * HTB)
#define PG8_SB(b, h) ((4 + (b) * 2 + (h)) * HTB)
#define PG8_STAGE(bufoff, gbase, voff) do { _Pragma("unroll") for (int _i = 0; _i < 2; ++_i) \
        __builtin_amdgcn_global_load_lds((const unsigned*)((const char*)(gbase) + (voff)[_i]), (PG8_LAS unsigned*)(lds + (bufoff) + ldsw + _i * 8192), 16, 0, 0); } while (0)
#define PG8_LDA(dst, b, h) do { _Pragma("unroll") for (int m = 0; m < 4; ++m) _Pragma("unroll") for (int k = 0; k < 2; ++k) dst[m][k] = *(const PG8_LAS bf16x8*)(lds + PG8_SA(b, h) + aoff + m * 2048 + k * 1024); } while (0)
#define PG8_LDB(dst, b, h) do { _Pragma("unroll") for (int n = 0; n < 2; ++n) _Pragma("unroll") for (int k = 0; k < 2; ++k) dst[n][k] = *(const PG8_LAS bf16x8*)(lds + PG8_SB(b, h) + boff + n * 2048 + k * 1024); } while (0)
#define PG8_MMA(ai, bj, At, Bt) do { __builtin_amdgcn_s_setprio(1); _Pragma("unroll") for (int m = 0; m < 4; ++m) _Pragma("unroll") for (int n = 0; n < 2; ++n) _Pragma("unroll") for (int k = 0; k < 2; ++k) \
        acc[ai][bj][m][n] = __builtin_amdgcn_mfma_f32_16x16x32_bf16(Bt[n][k], At[m][k], acc[ai][bj][m][n], 0, 0, 0); __builtin_amdgcn_s_setprio(0); } while (0)
#define PG8_WAIT_V(n) asm volatile("s_waitcnt vmcnt(" #n ")" ::: "memory")
#define PG8_WAIT_L(n) asm volatile("s_waitcnt lgkmcnt(" #n ")" ::: "memory")
#define PG8_BAR __builtin_amdgcn_s_barrier()
#define PG8_SCHED __builtin_amdgcn_sched_barrier(0)
    Unit cur, nxt; int ui = 0;
    if (!S.next(0, cur)) return;
    f32x4 acc[2][2][4][2];
#pragma unroll
    for (int a = 0; a < 2; ++a)
#pragma unroll
        for (int b = 0; b < 2; ++b)
#pragma unroll
            for (int m = 0; m < 4; ++m)
#pragma unroll
                for (int n = 0; n < 2; ++n) acc[a][b][m][n] = (f32x4){0.f, 0.f, 0.f, 0.f};
    bf16x8 At[4][2], B0[2][2], B1[2][2];
    const char* cA = (const char*)g.A + (size_t)cur.pm * tstep + (size_t)cur.k0 * 2; const char* cB = (const char*)g.Bt + (size_t)cur.pn * tstep + (size_t)cur.k0 * 2;
    S.a_ready(cur);
    if constexpr (SP2) {
        PG8_STAGE(PG8_SB(0, 0), cB, voffB); PG8_STAGE(PG8_SB(0, 1), cB + hstep, voffB); PG8_STAGE(PG8_SA(0, 0), cA, voffA); PG8_STAGE(PG8_SA(0, 1), cA + hstep, voffA);
        if (wr == 1) PG8_BAR;
        PG8_WAIT_V(2); PG8_BAR;
        PG8_STAGE(PG8_SB(1, 0), cB + kstep, voffB); PG8_STAGE(PG8_SA(1, 0), cA + kstep, voffA); PG8_STAGE(PG8_SB(1, 1), cB + hstep + kstep, voffB);
        PG8_WAIT_V(6); PG8_BAR;
    } else {
        PG8_STAGE(PG8_SB(0, 0), cB, voffB); PG8_STAGE(PG8_SA(0, 0), cA, voffA); PG8_STAGE(PG8_SB(0, 1), cB + hstep, voffB); PG8_STAGE(PG8_SA(0, 1), cA + hstep, voffA);
        if (wr == 1) PG8_BAR;
        PG8_WAIT_V(4); PG8_BAR;
        PG8_STAGE(PG8_SB(1, 0), cB + kstep, voffB); PG8_STAGE(PG8_SA(1, 0), cA + kstep, voffA); PG8_STAGE(PG8_SB(1, 1), cB + hstep + kstep, voffB);
        PG8_WAIT_V(6); PG8_BAR;
    }
    for (;;) {
        const bool has_next = S.next(ui + 1, nxt);
        const char* nA = has_next ? (const char*)g.A + (size_t)nxt.pm * tstep + (size_t)nxt.k0 * 2 : cA; const char* nB = has_next ? (const char*)g.Bt + (size_t)nxt.pn * tstep + (size_t)nxt.k0 * 2 : cB;
        const int nt = cur.nt;
        for (int t = 0; t < nt; t += 2) {
            const bool last = (t == nt - 2);
            const char* a1 = cA + (size_t)(t + 1) * kstep;
            const char* a2 = last ? nA : cA + (size_t)(t + 2) * kstep; const char* b2 = last ? nB : cB + (size_t)(t + 2) * kstep;
            const char* a3 = a2 + kstep; const char* b3 = b2 + kstep;
            if (last && has_next) S.a_ready(nxt);
            if constexpr (SP2) {
            PG8_LDB(B0, 0, 0); PG8_LDB(B1, 0, 1); PG8_SCHED; PG8_LDA(At, 0, 0); PG8_STAGE(PG8_SA(1, 1), a1 + hstep, voffA);
            PG8_WAIT_V(8); PG8_WAIT_L(0); PG8_BAR; PG8_MMA(0, 0, At, B0); PG8_MMA(0, 1, At, B1); PG8_BAR; PG8_SCHED;
            PG8_LDA(At, 0, 1); PG8_STAGE(PG8_SB(0, 0), b2, voffB); PG8_STAGE(PG8_SB(0, 1), b2 + hstep, voffB); PG8_STAGE(PG8_SA(0, 0), a2, voffA);
            PG8_WAIT_V(8); PG8_WAIT_L(0); PG8_BAR; PG8_MMA(1, 0, At, B0); PG8_MMA(1, 1, At, B1); PG8_BAR; PG8_SCHED;
            PG8_LDB(B0, 1, 0); PG8_LDB(B1, 1, 1); PG8_SCHED; PG8_LDA(At, 1, 0); PG8_STAGE(PG8_SA(0, 1), a2 + hstep, voffA);
            PG8_WAIT_V(8); PG8_WAIT_L(0); PG8_BAR; PG8_MMA(0, 0, At, B0); PG8_MMA(0, 1, At, B1); PG8_BAR; PG8_SCHED;
            PG8_LDA(At, 1, 1); PG8_STAGE(PG8_SB(1, 0), b3, voffB); PG8_STAGE(PG8_SB(1, 1), b3 + hstep, voffB); PG8_STAGE(PG8_SA(1, 0), a3, voffA);
            PG8_WAIT_V(8); PG8_WAIT_L(0); PG8_BAR; PG8_MMA(1, 0, At, B0); PG8_MMA(1, 1, At, B1); PG8_BAR; PG8_SCHED;
            } else {
            PG8_LDB(B0, 0, 0); PG8_SCHED; PG8_LDA(At, 0, 0); PG8_STAGE(PG8_SA(1, 1), a1 + hstep, voffA);
            PG8_WAIT_L(8); PG8_BAR; PG8_WAIT_L(0); PG8_MMA(0, 0, At, B0); PG8_BAR; PG8_SCHED;
            PG8_LDB(B1, 0, 1); PG8_STAGE(PG8_SB(0, 0), b2, voffB);
            PG8_BAR; PG8_WAIT_L(0); PG8_MMA(0, 1, At, B1); PG8_BAR;
            PG8_LDA(At, 0, 1); PG8_STAGE(PG8_SA(0, 0), a2, voffA);
            PG8_BAR; PG8_WAIT_L(0); PG8_MMA(1, 0, At, B0); PG8_BAR; PG8_SCHED;
            PG8_STAGE(PG8_SB(0, 1), b2 + hstep, voffB);
            PG8_WAIT_V(6); PG8_BAR; PG8_MMA(1, 1, At, B1); PG8_BAR;
            PG8_LDB(B0, 1, 0); PG8_SCHED; PG8_LDA(At, 1, 0); PG8_STAGE(PG8_SA(0, 1), a2 + hstep, voffA);
            PG8_WAIT_L(8); PG8_BAR; PG8_WAIT_L(0); PG8_MMA(0, 0, At, B0); PG8_BAR; PG8_SCHED;
            PG8_LDB(B1, 1, 1); PG8_STAGE(PG8_SB(1, 0), b3, voffB);
            PG8_BAR; PG8_WAIT_L(0); PG8_MMA(0, 1, At, B1); PG8_BAR;
            PG8_LDA(At, 1, 1); PG8_STAGE(PG8_SA(1, 0), a3, voffA);
            PG8_BAR; PG8_WAIT_L(0); PG8_MMA(1, 0, At, B0); PG8_BAR; PG8_SCHED;
            PG8_STAGE(PG8_SB(1, 1), b3 + hstep, voffB);
            PG8_WAIT_V(6); PG8_BAR; PG8_MMA(1, 1, At, B1); PG8_BAR;
            }
        }
        if constexpr (ALIGN_EPI) { if (wr == 0) PG8_BAR; }
        if constexpr (!Epi::AFTER_DRAIN) { E(acc, cur, wr, wc, fr, fq); S.done(cur); }
        if (!has_next) break;
#pragma unroll
        for (int a = 0; a < 2; ++a)
#pragma unroll
            for (int b = 0; b < 2; ++b)
#pragma unroll
                for (int m = 0; m < 4; ++m)
#pragma unroll
                    for (int n = 0; n < 2; ++n) acc[a][b][m][n] = (f32x4){0.f, 0.f, 0.f, 0.f};
        cur = nxt; cA = nA; cB = nB; ++ui;
        if constexpr (ALIGN_EPI) { if (wr == 1) PG8_BAR; }
    }
    PG8_WAIT_V(0);
    if constexpr (!ALIGN_EPI) { if (wr == 0) PG8_BAR; }
    PG8_BAR;
    if constexpr (Epi::AFTER_DRAIN) { E.fused(acc, cur, wr, wc, fr, fq, lds, wid, lane); S.done(cur); }
#undef PG8_SA
#undef PG8_SB
#undef PG8_STAGE
#undef PG8_LDA
#undef PG8_LDB
#undef PG8_MMA
#undef PG8_WAIT_V
#undef PG8_WAIT_L
#undef PG8_BAR
#undef PG8_SCHED
}
}

#define LAS __attribute__((address_space(3)))
typedef unsigned short bf16;
typedef pg8::bf16x8 bf16x8;
typedef pg8::f32x4 f32x4;
typedef pg8::u32x4 u32x4;
typedef unsigned u32x2 __attribute__((ext_vector_type(2)));

constexpr int DM = 1024, NB = 4, SEQ = 4096, DEPTH = 4, CTXL = 256, FF = 2816, INW = 3072;
constexpr int ML = NB * SEQ, MC = NB * CTXL, MT = ML + MC;
constexpr int NMODV = 9 * DM;
constexpr int PHW = 1280, PAW = 1280, VTOK = SEQ + CTXL;
constexpr int NCH = 68;
constexpr int NHU = NB * 4 * 2 * NCH;
constexpr float EPS = 1e-6f;

constexpr size_t MiB = 1u << 20;
constexpr size_t WS_BAR = 1 * MiB + 32768, BAR_BYTES = 16384;
constexpr size_t WS_MODV = 0, WS_LB = 1 * MiB, WS_ROPE = 1 * MiB + 65536, WS_DEC = 1 * MiB + 131072;
constexpr size_t WS_X = 2 * MiB, WS_XN = 70 * MiB, WS_O = 104 * MiB, WS_U = 138 * MiB, WS_PH = WS_U, WS_PA = 232 * MiB, WS_VT = 275 * MiB, WS_SLOC = 292 * MiB, WS_W = 326 * MiB;
constexpr size_t W13_E = (size_t)2 * FF * DM, W2_E = (size_t)DM * FF, WIN_E = (size_t)INW * DM, WOUT_E = (size_t)DM * DM;
constexpr size_t WL_E = 2 * W13_E + 2 * W2_E + WIN_E + WOUT_E;
constexpr size_t WS_END = WS_W + 4 * WL_E * 2;
static_assert(WS_U + (size_t)MT * FF * 2 <= WS_PA && WS_PH + (size_t)MT * PHW * 4 <= WS_PA && WS_PA + (size_t)MT * PAW * 2 <= WS_VT && WS_VT + (size_t)NB * 8 * 64 * VTOK * 2 <= WS_SLOC && WS_SLOC + (size_t)NHU * 4096 * 4 <= WS_W, "ws map");
static_assert(WS_DEC + (size_t)NHU * 64 * 4 <= WS_X && WS_X + (size_t)MT * DM * 4 <= WS_XN && WS_XN + (size_t)MT * DM * 2 <= WS_O && WS_O + (size_t)MT * DM * 2 <= WS_U, "ws map 2");

constexpr int LDS_BYTES = 163840;
constexpr int NPHASE = 2 + 12 * DEPTH;

struct Args {
    const float *x, *c, *ctx, *c_ctx, *ada_w, *ada_b, *norm_g, *w1, *w3, *w2, *w_in, *w_out, *lb_logits, *hg_norm_g, *rpb, *sink, *final_g;
    float* out; unsigned char* ws; int ph_lo, ph_hi;
};

typedef const __attribute__((address_space(4))) Args* ArgsP;
__device__ __forceinline__ unsigned pk2(float lo, float hi) { return pg8::cvt_pk_bf16(lo, hi); }
__device__ __forceinline__ unsigned f2bf(float f) { return pg8::cvt_pk_bf16(f, 0.f) & 0xffffu; }
__device__ __forceinline__ float xmax16(float x) { const unsigned u = __builtin_bit_cast(unsigned, x); const auto r = __builtin_amdgcn_permlane16_swap(u, u, false, false); const unsigned r0 = r[0], r1 = r[1]; return fmaxf(__builtin_bit_cast(float, r0), __builtin_bit_cast(float, r1)); }
__device__ __forceinline__ float xmax32(float x) { const unsigned u = __builtin_bit_cast(unsigned, x); const auto r = __builtin_amdgcn_permlane32_swap(u, u, false, false); const unsigned r0 = r[0], r1 = r[1]; return fmaxf(__builtin_bit_cast(float, r0), __builtin_bit_cast(float, r1)); }
__device__ __forceinline__ float xsum16(float x) { const unsigned u = __builtin_bit_cast(unsigned, x); const auto r = __builtin_amdgcn_permlane16_swap(u, u, false, false); const unsigned r0 = r[0], r1 = r[1]; return __builtin_bit_cast(float, r0) + __builtin_bit_cast(float, r1); }
__device__ __forceinline__ float xsum32(float x) { const unsigned u = __builtin_bit_cast(unsigned, x); const auto r = __builtin_amdgcn_permlane32_swap(u, u, false, false); const unsigned r0 = r[0], r1 = r[1]; return __builtin_bit_cast(float, r0) + __builtin_bit_cast(float, r1); }
__device__ __forceinline__ float wave_sum(float v) {
#pragma unroll
    for (int o = 1; o < 16; o <<= 1) v += __shfl_xor(v, o);
    return xsum32(xsum16(v));
}
__device__ __forceinline__ float sigmoidf_(float z) { return __builtin_amdgcn_rcpf(1.0f + __builtin_amdgcn_exp2f(-1.4426950408889634f * z)); }
__device__ __forceinline__ float siluf_(float z) { return z * __builtin_amdgcn_rcpf(1.0f + __builtin_amdgcn_exp2f(-1.4426950408889634f * z)); }
__device__ __forceinline__ bf16* wptr(unsigned char* ws, int l) { return (bf16*)(ws + WS_W) + (size_t)l * WL_E; }
__device__ __forceinline__ bf16* w13p(unsigned char* ws, int l, int s) { return wptr(ws, l) + (size_t)s * W13_E; }
__device__ __forceinline__ bf16* w2p(unsigned char* ws, int l, int s) { return wptr(ws, l) + 2 * W13_E + (size_t)s * W2_E; }
__device__ __forceinline__ bf16* winp(unsigned char* ws, int l) { return wptr(ws, l) + 2 * W13_E + 2 * W2_E; }
__device__ __forceinline__ bf16* woutp(unsigned char* ws, int l) { return wptr(ws, l) + 2 * W13_E + 2 * W2_E + WIN_E; }

using pg8::Unit;
struct EpiSwiglu {
    static constexpr bool PERM = false, AFTER_DRAIN = false;
    bf16* U;
    __device__ __forceinline__ void operator()(const f32x4 (&acc)[2][2][4][2], const Unit& u, int wr, int wc, int fr, int fq) const {
        const int row0 = u.pm * 256 + wr * 64 + fr, col0 = u.pn * 128 + wc * 16 + 4 * fq;
#pragma unroll
        for (int ai = 0; ai < 2; ++ai)
#pragma unroll
            for (int m = 0; m < 4; ++m) { bf16* rp = U + (size_t)(row0 + ai * 128 + m * 16) * FF + col0;
#pragma unroll
                for (int bj = 0; bj < 2; ++bj) { const f32x4 a = acc[ai][bj][m][0], b = acc[ai][bj][m][1];
                    u32x2 w; w.x = pg8::cvt_pk_bf16(siluf_(a[0]) * b[0], siluf_(a[1]) * b[1]); w.y = pg8::cvt_pk_bf16(siluf_(a[2]) * b[2], siluf_(a[3]) * b[3]);
                    *(u32x2*)(rp + bj * 64) = w; } }
    }
};
struct EpiResid {
    static constexpr bool PERM = false, AFTER_DRAIN = false;
    float* X; const float* gate  ; float coef; int ntfull; float* PART; int ntsplit;
    __device__ __forceinline__ void operator()(const f32x4 (&acc)[2][2][4][2], const Unit& u, int wr, int wc, int fr, int fq) const {
        const int row0 = u.pm * 256 + wr * 64 + fr, col0 = u.pn * 256 + wc * 32 + 4 * fq;
        const int bi = u.pm < 64 ? (u.pm >> 4) : 4;
        const float* gp = gate + (size_t)bi * NMODV + col0;
        const bool full = u.nt == ntfull;
        float* base = full ? X + (size_t)row0 * DM + col0 : PART + ((size_t)(u.k0 / (ntsplit * 64)) * MC + (row0 - ML)) * DM + col0;
#pragma unroll
        for (int bj = 0; bj < 2; ++bj)
#pragma unroll
            for (int n = 0; n < 2; ++n) { const f32x4 gv = *(const f32x4*)(gp + bj * 128 + n * 16) * coef;
                float* cb = base + bj * 128 + n * 16;
                if (full) {
                    f32x4 xv[2][4];
#pragma unroll
                    for (int ai = 0; ai < 2; ++ai)
#pragma unroll
                        for (int m = 0; m < 4; ++m) xv[ai][m] = *(const f32x4*)(cb + (size_t)(ai * 128 + m * 16) * DM);
#pragma unroll
                    for (int ai = 0; ai < 2; ++ai)
#pragma unroll
                        for (int m = 0; m < 4; ++m) *(f32x4*)(cb + (size_t)(ai * 128 + m * 16) * DM) = xv[ai][m] + gv * acc[ai][bj][m][n];
                } else {
#pragma unroll
                    for (int ai = 0; ai < 2; ++ai)
#pragma unroll
                        for (int m = 0; m < 4; ++m) *(f32x4*)(cb + (size_t)(ai * 128 + m * 16) * DM) = gv * acc[ai][bj][m][n]; } }
    }
};
struct EpiIn {
    static constexpr bool PERM = false, AFTER_DRAIN = false;
    float* PH; bf16* PA; bf16* VT; const float* lb  ; const float* rope  ;
    __device__ __forceinline__ void operator()(const f32x4 (&acc)[2][2][4][2], const Unit& u, int wr, int wc, int fr, int fq) const {
        const int rloc0 = wr * 64 + fr;
        const bool isctx = u.pm >= 64;
        const int vb = isctx ? (u.pm - 64) : (u.pm >> 4);
        const int tok0 = isctx ? SEQ : (u.pm & 15) * 256;
#pragma unroll
        for (int bj = 0; bj < 2; ++bj) {
            const int cbase = u.pn * 256 + bj * 128 + wc * 32;
            if (cbase < 1280) {
                const int blk = cbase >> 8;
#pragma unroll
                for (int n = 0; n < 2; ++n) { const int col = cbase + 16 * n + 4 * fq;
                    f32x4 lbv = (f32x4){0.f, 0.f, 0.f, 0.f};
                    if (blk == 1 || blk == 2) lbv = *(const f32x4*)(lb + (blk - 1) * 256 + (col - 256 * blk));
#pragma unroll
                    for (int ai = 0; ai < 2; ++ai)
#pragma unroll
                        for (int m = 0; m < 4; ++m) { f32x4 v = acc[ai][bj][m][n], o;
                            if (blk == 0 || blk == 4) { o[0] = siluf_(v[0]); o[1] = siluf_(v[1]); o[2] = siluf_(v[2]); o[3] = siluf_(v[3]); }
                            else if (blk == 3) o = v;
                            else {
#pragma unroll
                                for (int j = 0; j < 4; ++j) o[j] = __logf(lbv[j] + (1.0f - lbv[j]) * sigmoidf_(v[j])); }
                            *(f32x4*)(PH + (size_t)(u.pm * 256 + rloc0 + ai * 128 + m * 16) * PHW + col) = o; } }
            } else {
                int kind, pcol = 0, vh = 0;
                float sc = 1.0f;
                if (cbase < 1664)      { kind = 0; pcol = cbase - 1280; sc = 0.125f * 1.4426950408889634f; }
                else if (cbase < 2048) { kind = 0; pcol = 384 + cbase - 1664; }
                else if (cbase < 2432) { kind = 2; vh = (cbase - 2048) >> 6; }
                else if (cbase < 2816) { kind = isctx ? 0 : 1; pcol = 768 + cbase - 2432; sc = 0.125f * 1.4426950408889634f; }
                else if (cbase < 2944) { kind = isctx ? 0 : 1; pcol = 1152 + cbase - 2816; }
                else                   { kind = 2; vh = 6 + ((cbase - 2944) >> 6); }
                if (kind == 2) {
                    const int d0 = (cbase & 63) + 4 * fq;
                    bf16* vp = VT + ((size_t)((vb * 8 + vh) * 64 + d0)) * VTOK + tok0 + rloc0;
#pragma unroll
                    for (int ai = 0; ai < 2; ++ai)
#pragma unroll
                        for (int m = 0; m < 4; ++m)
#pragma unroll
                            for (int n = 0; n < 2; ++n) { const f32x4 v = acc[ai][bj][m][n];
#pragma unroll
                                for (int j = 0; j < 4; ++j) vp[(size_t)(16 * n + j) * VTOK + ai * 128 + m * 16] = (bf16)f2bf(v[j]); }
                } else if (kind == 0) {
#pragma unroll
                    for (int ai = 0; ai < 2; ++ai)
#pragma unroll
                        for (int m = 0; m < 4; ++m) { bf16* rp = PA + (size_t)(u.pm * 256 + rloc0 + ai * 128 + m * 16) * PAW + pcol + 4 * fq;
#pragma unroll
                            for (int n = 0; n < 2; ++n) { const f32x4 v = acc[ai][bj][m][n] * sc; u32x2 w; w.x = pg8::cvt_pk_bf16(v[0], v[1]); w.y = pg8::cvt_pk_bf16(v[2], v[3]); *(u32x2*)(rp + 16 * n) = w; } }
                } else {
                    const bool colaxis = (cbase & 32) != 0;
#pragma unroll
                    for (int ai = 0; ai < 2; ++ai)
#pragma unroll
                        for (int m = 0; m < 4; ++m) { const int r = u.pm * 256 + rloc0 + ai * 128 + m * 16, t = r & (SEQ - 1), pos = colaxis ? (t & 63) : (t >> 6);
                            const f32x4 cs = *(const f32x4*)(rope + pos * 16 + 4 * fq), sn = *(const f32x4*)(rope + 1024 + pos * 16 + 4 * fq);
                            const f32x4 x1 = acc[ai][bj][m][0], x2 = acc[ai][bj][m][1];
                            const f32x4 o1 = (x1 * cs - x2 * sn) * sc, o2 = (x1 * sn + x2 * cs) * sc;
                            bf16* rp = PA + (size_t)r * PAW + pcol + 4 * fq;
                            u32x2 w; w.x = pg8::cvt_pk_bf16(o1[0], o1[1]); w.y = pg8::cvt_pk_bf16(o1[2], o1[3]); *(u32x2*)rp = w;
                            w.x = pg8::cvt_pk_bf16(o2[0], o2[1]); w.y = pg8::cvt_pk_bf16(o2[2], o2[3]); *(u32x2*)(rp + 16) = w; }
                }
            }
        }
    }
};

struct EpiAll {
    static constexpr bool PERM = false, AFTER_DRAIN = false;
    unsigned char* ws; int mode  ; int l, gi; float coef; int ntfull, ntsplit;
    __device__ __forceinline__ void operator()(const f32x4 (&acc)[2][2][4][2], const Unit& u, int wr, int wc, int fr, int fq) const {
        if (mode == 0) { EpiSwiglu E{(bf16*)(ws + WS_U)}; E(acc, u, wr, wc, fr, fq); }
        else if (mode == 1) { EpiResid E{(float*)(ws + WS_X), (const float*)(ws + WS_MODV) + (size_t)l * 5 * NMODV + gi * DM, coef, ntfull, (float*)(ws + WS_SLOC), ntsplit}; E(acc, u, wr, wc, fr, fq); }
        else { EpiIn E{(float*)(ws + WS_PH), (bf16*)(ws + WS_PA), (bf16*)(ws + WS_VT), (const float*)(ws + WS_LB) + l * 512, (const float*)(ws + WS_ROPE)}; E(acc, u, wr, wc, fr, fq); }
    }
};

__device__ __forceinline__ void p0_transpose_item(const float* W, int K, int N, bf16* WT, int mode, LAS float* scr, int item, int lane) {
    const int nblk = N / 32, kb = item / nblk, nb = item % nblk, k0 = 64 * kb, n0 = 32 * nb;
    float tv[32];
#pragma unroll
    for (int i = 0; i < 32; ++i) { const int kk = 2 * i + (lane >> 5); tv[i] = W[(size_t)(k0 + kk) * N + n0 + (lane & 31)]; }
#pragma unroll
    for (int i = 0; i < 32; ++i) { const int kk = 2 * i + (lane >> 5); scr[kk * 33 + (lane & 31)] = tv[i]; }
    asm volatile("s_waitcnt lgkmcnt(0)" ::: "memory");
    const int c = lane & 7;
#pragma unroll
    for (int j = 0; j < 4; ++j) { const int n = (lane >> 3) + 8 * j; const LAS float* s = scr + (8 * c) * 33 + n;
        u32x4 o; o.x = pk2(s[0 * 33], s[1 * 33]); o.y = pk2(s[2 * 33], s[3 * 33]); o.z = pk2(s[4 * 33], s[5 * 33]); o.w = pk2(s[6 * 33], s[7 * 33]);
        const int ns = n0 + n; const int nd = mode == 0 ? ns : (32 * (ns >> 4) + (ns & 15) + (mode == 2 ? 16 : 0));
        *(u32x4*)(WT + (size_t)nd * K + k0 + 8 * c) = o; }
    asm volatile("s_waitcnt lgkmcnt(0)" ::: "memory");
}

__device__ __forceinline__ void phase_prologue(ArgsP a, LAS unsigned char* L, int tid, int lane, int wave) {
    asm volatile("" : "+s"(a) :: "memory");
    unsigned char* ws = a->ws;
    float* MODV = (float*)(ws + WS_MODV);
    LAS float* sv = (LAS float*)L;
    LAS float* part = (LAS float*)(L + 20480);
    for (int i = tid; i < 5 * DM; i += 512) { const int bi = i >> 10, k = i & 1023; const float v = bi < 4 ? a->c[bi * DM + k] : a->c_ctx[k]; sv[i] = siluf_(v); }
    __syncthreads();
    for (int item = blockIdx.x; item < DEPTH * (NMODV / 64); item += gridDim.x) {
        const int l = item / (NMODV / 64), cgp = item % (NMODV / 64);
        const float* wp = a->ada_w + (size_t)l * DM * NMODV + (size_t)(128 * wave) * NMODV + cgp * 64 + lane;
        float ac[5] = {0.f, 0.f, 0.f, 0.f, 0.f};
        for (int k0 = 0; k0 < 128; k0 += 32) { float w[32];
#pragma unroll
            for (int j = 0; j < 32; ++j) w[j] = wp[(size_t)(k0 + j) * NMODV];
#pragma unroll
            for (int j = 0; j < 32; ++j)
#pragma unroll
                for (int bi = 0; bi < 5; ++bi) ac[bi] += sv[bi * DM + 128 * wave + k0 + j] * w[j]; }
#pragma unroll
        for (int bi = 0; bi < 5; ++bi) part[(wave * 5 + bi) * 64 + lane] = ac[bi];
        __syncthreads();
        if (tid < 320) { const int bi = tid >> 6, ln = tid & 63; float s = a->ada_b[l * NMODV + cgp * 64 + ln];
#pragma unroll
            for (int w = 0; w < 8; ++w) s += part[(w * 5 + bi) * 64 + ln];
            MODV[(size_t)(l * 5 + bi) * NMODV + cgp * 64 + ln] = s; }
        __syncthreads();
    }
    {
        LAS float* scr = (LAS float*)(L + 32768 + wave * 8448);
        const int gw = blockIdx.x * 8 + wave, NGW = gridDim.x * 8;
        constexpr int I1 = (DM / 64) * (FF / 32), I2 = (FF / 64) * (DM / 32), IIN = (DM / 64) * (INW / 32), IOUT = (DM / 64) * (DM / 32);
        constexpr int PERL = 4 * I1 + 2 * I2 + IIN + IOUT;
        for (int it = gw; it < DEPTH * PERL; it += NGW) {
            const int l = it / PERL; int r = it % PERL;
            if (r < 4 * I1) { const int q = r / I1, s = q >> 1, which = q & 1; r -= q * I1;
                const float* src = (which ? a->w3 : a->w1) + (size_t)(l * 2 + s) * DM * FF;
                p0_transpose_item(src, DM, FF, w13p(ws, l, s), 1 + which, scr, r, lane); continue; }
            r -= 4 * I1;
            if (r < 2 * I2) { const int s = r / I2; r -= s * I2; p0_transpose_item(a->w2 + (size_t)(l * 2 + s) * FF * DM, FF, DM, w2p(ws, l, s), 0, scr, r, lane); continue; }
            r -= 2 * I2;
            if (r < IIN) { p0_transpose_item(a->w_in + (size_t)l * DM * INW, DM, INW, winp(ws, l), 0, scr, r, lane); continue; }
            r -= IIN;
            p0_transpose_item(a->w_out + (size_t)l * DM * DM, DM, DM, woutp(ws, l), 0, scr, r, lane);
        }
    }
    {
        f32x4* X4 = (f32x4*)(ws + WS_X); const f32x4* x4 = (const f32x4*)a->x; const f32x4* c4 = (const f32x4*)a->ctx;
        const size_t n1 = (size_t)ML * DM / 4, n2 = (size_t)MC * DM / 4, gs = (size_t)gridDim.x * 512;
        for (size_t i = (size_t)blockIdx.x * 512 + tid; i < n1; i += gs) X4[i] = x4[i];
        for (size_t i = (size_t)blockIdx.x * 512 + tid; i < n2; i += gs) X4[n1 + i] = c4[i];
    }
    if (blockIdx.x == 0) {
        float* rope = (float*)(ws + WS_ROPE);
        for (int i = tid; i < 1024; i += 512) { const int pos = i >> 4, f = i & 15; const float inv = powf(10000.0f, -(float)f / 16.0f), ang = (float)pos * inv; rope[i] = cosf(ang); rope[1024 + i] = sinf(ang); }
        float* LB = (float*)(ws + WS_LB);
        { const int i = tid;
            float lg[DEPTH], mx = -1e30f;
#pragma unroll
            for (int l = 0; l < DEPTH; ++l) { lg[l] = a->lb_logits[l * 512 + i]; mx = fmaxf(mx, lg[l]); }
            float sum = 0.f;
#pragma unroll
            for (int l = 0; l < DEPTH; ++l) { lg[l] = expf(lg[l] - mx); sum += lg[l]; }
            float cum = 0.f; const float s0 = lg[0] / sum;
#pragma unroll
            for (int l = 0; l < DEPTH; ++l) { cum += lg[l] / sum; LB[l * 512 + i] = cum - s0; } }
    }
}

__device__ __forceinline__ void phase_norm(ArgsP a, int l, int sub, int nrows, int nsplit, int lane, int wave) {
    asm volatile("" : "+s"(a) :: "memory");
    unsigned char* ws = a->ws;
    const float* X = (const float*)(ws + WS_X); float* Xw = (float*)(ws + WS_X); const float* PART = (const float*)(ws + WS_SLOC); bf16* XN = (bf16*)(ws + WS_XN);
    const float* g = a->norm_g + (size_t)(l * 3 + sub) * DM;
    const float* mv = (const float*)(ws + WS_MODV) + (size_t)l * 5 * NMODV;
    if (nrows > ML) {
        const float* sh = mv + (size_t)4 * NMODV + (3 * sub) * DM, *sc = sh + DM;
        for (int r = blockIdx.x * 8 + wave; r < MC; r += gridDim.x * 8) {
            const int row = ML + r;
            f32x4 v[4], pv[6][4];
#pragma unroll
            for (int j = 0; j < 4; ++j) v[j] = ((const f32x4*)(X + (size_t)row * DM))[lane + 64 * j];
#pragma unroll
            for (int sp = 0; sp < 6; ++sp) if (sp < nsplit) {
#pragma unroll
                for (int j = 0; j < 4; ++j) pv[sp][j] = ((const f32x4*)(PART + ((size_t)sp * MC + r) * DM))[lane + 64 * j]; }
#pragma unroll
            for (int sp = 0; sp < 6; ++sp) if (sp < nsplit) {
#pragma unroll
                for (int j = 0; j < 4; ++j) v[j] = v[j] + pv[sp][j]; }
            float ss = 0.f;
#pragma unroll
            for (int j = 0; j < 4; ++j) { ((f32x4*)(Xw + (size_t)row * DM))[lane + 64 * j] = v[j]; ss += (v[j][0] * v[j][0] + v[j][1] * v[j][1]) + (v[j][2] * v[j][2] + v[j][3] * v[j][3]); }
            const float rstd = rsqrtf(wave_sum(ss) * (1.0f / DM) + EPS);
            u32x2* o = (u32x2*)(XN + (size_t)row * DM) + lane;
#pragma unroll
            for (int j = 0; j < 4; ++j) { const f32x4 gg = ((const f32x4*)g)[lane + 64 * j], s4 = ((const f32x4*)sc)[lane + 64 * j], h4 = ((const f32x4*)sh)[lane + 64 * j];
                const f32x4 y = v[j] * rstd * gg * (s4 + 1.0f) + h4;
                u32x2 w; w.x = pg8::cvt_pk_bf16(y[0], y[1]); w.y = pg8::cvt_pk_bf16(y[2], y[3]); o[64 * j] = w; }
        }
        nrows = ML;
    }
    const int G = gridDim.x, vb = (G % 8 == 0) ? ((int)(blockIdx.x & 7) * (G >> 3) + (int)(blockIdx.x >> 3)) : (int)blockIdx.x;
    for (int wi = vb * 8 + wave; wi * 8 < nrows; wi += G * 8) {
    const int rbeg = wi * 8;
    int cur_bi = -1; f32x4 GS[4], HH[4];
    for (int base = rbeg; base < rbeg + 8; base += 4) {
        f32x4 v[4][4]; float s[4];
#pragma unroll
        for (int q = 0; q < 4; ++q) { const f32x4* xr = (const f32x4*)(X + (size_t)(base + q) * DM) + lane;
#pragma unroll
            for (int j = 0; j < 4; ++j) v[q][j] = xr[64 * j]; }
#pragma unroll
        for (int q = 0; q < 4; ++q) { s[q] = 0.f;
#pragma unroll
            for (int j = 0; j < 4; ++j) s[q] += (v[q][j][0] * v[q][j][0] + v[q][j][1] * v[q][j][1]) + (v[q][j][2] * v[q][j][2] + v[q][j][3] * v[q][j][3]); }
#pragma unroll
        for (int o = 1; o < 64; o <<= 1) { s[0] += __shfl_xor(s[0], o); s[1] += __shfl_xor(s[1], o); s[2] += __shfl_xor(s[2], o); s[3] += __shfl_xor(s[3], o); }
#pragma unroll
        for (int q = 0; q < 4; ++q) { const int row = base + q;
            const int bi = row < ML ? row / SEQ : 4;
            if (bi != cur_bi) {
                const float* sh = mv + (size_t)bi * NMODV + (3 * sub) * DM, *sc = sh + DM;
#pragma unroll
                for (int j = 0; j < 4; ++j) { GS[j] = ((const f32x4*)g)[lane + 64 * j] * (((const f32x4*)sc)[lane + 64 * j] + 1.0f); HH[j] = ((const f32x4*)sh)[lane + 64 * j]; }
                cur_bi = bi; }
            const float rstd = rsqrtf(s[q] * (1.0f / DM) + EPS);
            u32x2* o = (u32x2*)(XN + (size_t)row * DM) + lane;
#pragma unroll
            for (int j = 0; j < 4; ++j) { const f32x4 y = v[q][j] * rstd * GS[j] + HH[j];
                u32x2 w; w.x = pg8::cvt_pk_bf16(y[0], y[1]); w.y = pg8::cvt_pk_bf16(y[2], y[3]); o[64 * j] = w; } }
    }
    }
}
__device__ __forceinline__ void phase_final(ArgsP a, int lane, int wave) {
    asm volatile("" : "+s"(a) :: "memory");
    const float* X = (const float*)(a->ws + WS_X);
    const int G = gridDim.x, vb = (G % 8 == 0) ? ((int)(blockIdx.x & 7) * (G >> 3) + (int)(blockIdx.x >> 3)) : (int)blockIdx.x;
    f32x4 FG[4];
#pragma unroll
    for (int j = 0; j < 4; ++j) FG[j] = ((const f32x4*)a->final_g)[lane + 64 * j];
    for (int wi = vb * 8 + wave; wi * 8 < ML; wi += G * 8)
    for (int base = wi * 8; base < wi * 8 + 8; base += 4) {
        f32x4 v[4][4]; float s[4];
#pragma unroll
        for (int q = 0; q < 4; ++q) { const f32x4* xr = (const f32x4*)(X + (size_t)(base + q) * DM) + lane;
#pragma unroll
            for (int j = 0; j < 4; ++j) v[q][j] = xr[64 * j]; }
#pragma unroll
        for (int q = 0; q < 4; ++q) { s[q] = 0.f;
#pragma unroll
            for (int j = 0; j < 4; ++j) s[q] += (v[q][j][0] * v[q][j][0] + v[q][j][1] * v[q][j][1]) + (v[q][j][2] * v[q][j][2] + v[q][j][3] * v[q][j][3]); }
#pragma unroll
        for (int o = 1; o < 64; o <<= 1) { s[0] += __shfl_xor(s[0], o); s[1] += __shfl_xor(s[1], o); s[2] += __shfl_xor(s[2], o); s[3] += __shfl_xor(s[3], o); }
#pragma unroll
        for (int q = 0; q < 4; ++q) { const float rstd = rsqrtf(s[q] * (1.0f / DM) + EPS);
            f32x4* o = (f32x4*)(a->out + (size_t)(base + q) * DM) + lane;
#pragma unroll
            for (int j = 0; j < 4; ++j) o[64 * j] = v[q][j] * rstd * FG[j]; }
    }
}
constexpr int HS = 72;
__device__ __forceinline__ int hg_row(int b, bool isctx, int lc, int dir, int s) {
    const int p = 64 * lc + s, Lm1 = isctx ? (CTXL - 1) : (SEQ - 1), tok = dir ? (Lm1 - p) : p;
    return isctx ? (ML + b * CTXL + tok) : (b * SEQ + tok);
}
__device__ __forceinline__ bf16x8 lds_frag(const LAS bf16* p) { return *(const LAS bf16x8*)p; }
__device__ __forceinline__ void phase_h1(ArgsP a, LAS unsigned char* L, int tid, int lane, int wave) {
    asm volatile("" : "+s"(a) :: "memory");
    unsigned char* ws = a->ws;
    const float* PH = (const float*)(ws + WS_PH); float* SLOC = (float*)(ws + WS_SLOC); float* DEC = (float*)(ws + WS_DEC);
    const int grp = wave >> 2, w4 = wave & 3;
    LAS unsigned char* GB = L + grp * 19456;
    LAS float* segtot = (LAS float*)GB;
    LAS bf16* KdT = (LAS bf16*)(GB + 1024);
    LAS bf16* VTl = KdT + 64 * HS;
    const int fr = lane & 15, g = lane >> 4;
    for (int pr = blockIdx.x; pr < NHU / 2; pr += gridDim.x) {
        const int unit = 2 * pr + grp;
        const int c = unit % NCH, dir = (unit / NCH) & 1, h = (unit / (2 * NCH)) & 3, b = unit / (8 * NCH);
        const bool isctx = c < 4; const int lc = isctx ? c : c - 4;
        float lf[16], cu[16], vv[16]; float run = 0.f;
#pragma unroll
        for (int i = 0; i < 16; ++i) { const size_t r = (size_t)hg_row(b, isctx, lc, dir, 16 * w4 + i) * PHW; lf[i] = PH[r + 256 * (1 + dir) + 64 * h + lane]; vv[i] = PH[r + 768 + 64 * h + lane]; }
#pragma unroll
        for (int i = 0; i < 16; ++i) { run += lf[i]; cu[i] = run; }
        segtot[w4 * 64 + lane] = run;
        __syncthreads();
        float P = 0.f, off = 0.f;
#pragma unroll
        for (int sg = 0; sg < 4; ++sg) { if (sg == w4) off = P; P += segtot[sg * 64 + lane]; }
        float kd[16];
#pragma unroll
        for (int i = 0; i < 16; ++i) kd[i] = (1.0f - __expf(lf[i])) * __expf(P - (cu[i] + off));
#pragma unroll
        for (int hh = 0; hh < 2; ++hh) {
            { u32x4 w; w.x = pk2(kd[8 * hh + 0], kd[8 * hh + 1]); w.y = pk2(kd[8 * hh + 2], kd[8 * hh + 3]); w.z = pk2(kd[8 * hh + 4], kd[8 * hh + 5]); w.w = pk2(kd[8 * hh + 6], kd[8 * hh + 7]); *(LAS u32x4*)(KdT + lane * HS + 16 * w4 + 8 * hh) = w; }
            { u32x4 w; w.x = pk2(vv[8 * hh + 0], vv[8 * hh + 1]); w.y = pk2(vv[8 * hh + 2], vv[8 * hh + 3]); w.z = pk2(vv[8 * hh + 4], vv[8 * hh + 5]); w.w = pk2(vv[8 * hh + 6], vv[8 * hh + 7]); *(LAS u32x4*)(VTl + lane * HS + 16 * w4 + 8 * hh) = w; } }
        if (w4 == 0) DEC[(size_t)unit * 64 + lane] = __expf(P);
        __syncthreads();
        const int kt = w4;
#pragma unroll
        for (int dt = 0; dt < 4; ++dt) { f32x4 acc = (f32x4){0.f, 0.f, 0.f, 0.f};
#pragma unroll
            for (int ks = 0; ks < 2; ++ks) acc = __builtin_amdgcn_mfma_f32_16x16x32_bf16(lds_frag(KdT + (16 * kt + fr) * HS + 32 * ks + 8 * g), lds_frag(VTl + (16 * dt + fr) * HS + 32 * ks + 8 * g), acc, 0, 0, 0);
            float* sp = SLOC + (size_t)unit * 4096 + (size_t)(16 * kt + 4 * g) * 64 + 16 * dt + fr;
#pragma unroll
            for (int j = 0; j < 4; ++j) sp[j * 64] = acc[j]; }
        __syncthreads();
    }
}
__device__ __forceinline__ void phase_h2(ArgsP a, int tid) {
    asm volatile("" : "+s"(a) :: "memory");
    float* SLOC = (float*)(a->ws + WS_SLOC); const float* DEC = (const float*)(a->ws + WS_DEC);
    for (int e = blockIdx.x * 512 + tid; e < NB * 4 * 2 * 4096; e += gridDim.x * 512) {
        const int chain = e >> 12, el = e & 4095; float* sp = SLOC + (size_t)chain * NCH * 4096 + el; const float* dp = DEC + (size_t)chain * NCH * 64 + (el >> 6);
        float S = 0.f;
        for (int c0 = 0; c0 < NCH; c0 += 4) { float sl[4], d[4];
#pragma unroll
            for (int i = 0; i < 4; ++i) { sl[i] = sp[(size_t)(c0 + i) * 4096]; d[i] = dp[(c0 + i) * 64]; }
#pragma unroll
            for (int i = 0; i < 4; ++i) { sp[(size_t)(c0 + i) * 4096] = S; S = d[i] * S + sl[i]; } }
    }
}
__device__ __forceinline__ void phase_h3(ArgsP a, LAS unsigned char* L, int l, bool need_ctx, int tid, int lane, int wave) {
    asm volatile("" : "+s"(a) :: "memory");
    unsigned char* ws = a->ws;
    const float* PH = (const float*)(ws + WS_PH); const float* SLOC = (const float*)(ws + WS_SLOC); bf16* O = (bf16*)(ws + WS_O);
    constexpr int DREG = 70656;
    const int dir = wave >> 2, w4 = wave & 3;
    LAS unsigned char* DB = L + dir * DREG;
    LAS float* segtot = (LAS float*)DB;
    LAS bf16* Qd = (LAS bf16*)(DB + 1024);
    LAS bf16* Qi = Qd + 64 * HS;
    LAS bf16* VTl = Qi + 64 * HS;
    LAS bf16* SpT = VTl + 64 * HS;
    LAS bf16* Ab = SpT + 64 * HS;
    LAS bf16* KS = Ab + 64 * HS;
    LAS float* Od = (LAS float*)(DB + 1024);
    const LAS float* Od0 = (const LAS float*)(L + 1024); const LAS float* Od1 = (const LAS float*)(L + DREG + 1024);
    const int fr = lane & 15, g = lane >> 4;
    const int tc0 = need_ctx ? 0 : 4, ntc = NCH - tc0, nunits = NB * 4 * ntc;
    for (int unit = blockIdx.x; unit < nunits; unit += gridDim.x) {
        const int tc = tc0 + unit % ntc, h = (unit / ntc) & 3, b = unit / (4 * ntc);
        const bool isctx = tc < 4; const int tcl = isctx ? tc : tc - 4, nch = isctx ? 4 : 64;
        const int lc = dir ? (nch - 1 - tcl) : tcl, c = isctx ? lc : 4 + lc;
        const size_t hu = (size_t)(((b * 4 + h) * 2 + dir) * NCH + c);
        float lf[16], cu[16], vv[16], qq[16], sp[16]; float run = 0.f;
#pragma unroll
        for (int i = 0; i < 16; ++i) { const size_t r = (size_t)hg_row(b, isctx, lc, dir, 16 * w4 + i) * PHW; lf[i] = PH[r + 256 * (1 + dir) + 64 * h + lane]; vv[i] = PH[r + 768 + 64 * h + lane]; qq[i] = PH[r + 64 * h + lane];
            sp[i] = SLOC[hu * 4096 + (size_t)(16 * w4 + i) * 64 + lane]; }
#pragma unroll
        for (int i = 0; i < 16; ++i) { run += lf[i]; cu[i] = run; }
        segtot[w4 * 64 + lane] = run;
        __syncthreads();
        float P = 0.f, Rr[4];
#pragma unroll
        for (int sg = 0; sg < 4; ++sg) { Rr[sg] = P; P += segtot[sg * 64 + lane]; }
        const int jb = w4;
        float Rj = Rr[0];
#pragma unroll
        for (int ii = 1; ii < 4; ++ii) if (ii == jb) Rj = Rr[ii];
#pragma unroll
        for (int i = 0; i < 16; ++i) { const int s = 16 * w4 + i; const float cs = cu[i] + Rj, kv = 1.0f - __expf(lf[i]);
            Qd[s * HS + lane] = (bf16)f2bf(qq[i] * __expf(cs));
            Qi[s * HS + lane] = (bf16)f2bf(qq[i] * __expf(cs - Rj));
#pragma unroll
            for (int ii = 0; ii < 4; ++ii) if (ii >= jb) { const int ro = (ii == 0 ? 0 : ii == 1 ? 16 : ii == 2 ? 48 : 96); KS[(ro + s) * HS + lane] = (bf16)f2bf(kv * __expf(Rr[ii] - cs)); } }
#pragma unroll
        for (int hh = 0; hh < 2; ++hh) {
            { u32x4 w; w.x = pk2(vv[8 * hh + 0], vv[8 * hh + 1]); w.y = pk2(vv[8 * hh + 2], vv[8 * hh + 3]); w.z = pk2(vv[8 * hh + 4], vv[8 * hh + 5]); w.w = pk2(vv[8 * hh + 6], vv[8 * hh + 7]); *(LAS u32x4*)(VTl + lane * HS + 16 * w4 + 8 * hh) = w; }
            { u32x4 w; w.x = pk2(sp[8 * hh + 0], sp[8 * hh + 1]); w.y = pk2(sp[8 * hh + 2], sp[8 * hh + 3]); w.z = pk2(sp[8 * hh + 4], sp[8 * hh + 5]); w.w = pk2(sp[8 * hh + 6], sp[8 * hh + 7]); *(LAS u32x4*)(SpT + lane * HS + 16 * w4 + 8 * hh) = w; } }
        __syncthreads();
        const int ib = w4;
        f32x4 acc[4];
#pragma unroll
        for (int dt = 0; dt < 4; ++dt) { acc[dt] = (f32x4){0.f, 0.f, 0.f, 0.f};
#pragma unroll
            for (int ks = 0; ks < 2; ++ks) acc[dt] = __builtin_amdgcn_mfma_f32_16x16x32_bf16(lds_frag(Qd + (16 * ib + fr) * HS + 32 * ks + 8 * g), lds_frag(SpT + (16 * dt + fr) * HS + 32 * ks + 8 * g), acc[dt], 0, 0, 0); }
        const int kro = (ib == 0 ? 0 : ib == 1 ? 16 : ib == 2 ? 48 : 96);
#pragma unroll
        for (int sb = 0; sb < 4; ++sb) {
            f32x4 cc = (f32x4){0.f, 0.f, 0.f, 0.f};
            if (sb <= ib) {
#pragma unroll
                for (int ks = 0; ks < 2; ++ks) cc = __builtin_amdgcn_mfma_f32_16x16x32_bf16(lds_frag(Qi + (16 * ib + fr) * HS + 32 * ks + 8 * g), lds_frag(KS + (kro + 16 * sb + fr) * HS + 32 * ks + 8 * g), cc, 0, 0, 0);
                if (sb == ib) {
#pragma unroll
                    for (int j = 0; j < 4; ++j) if (fr > 4 * g + j) cc[j] = 0.f; }
            }
#pragma unroll
            for (int j = 0; j < 4; ++j) Ab[(16 * ib + 4 * g + j) * HS + 16 * sb + fr] = (bf16)f2bf(cc[j]); }
        __syncthreads();
#pragma unroll
        for (int ks = 0; ks < 2; ++ks) if (ks <= (ib >> 1)) { const bf16x8 af = lds_frag(Ab + (16 * ib + fr) * HS + 32 * ks + 8 * g);
#pragma unroll
            for (int dt = 0; dt < 4; ++dt) acc[dt] = __builtin_amdgcn_mfma_f32_16x16x32_bf16(af, lds_frag(VTl + (16 * dt + fr) * HS + 32 * ks + 8 * g), acc[dt], 0, 0, 0); }
#pragma unroll
        for (int dt = 0; dt < 4; ++dt)
#pragma unroll
            for (int j = 0; j < 4; ++j) { const int t = 16 * ib + 4 * g + j, tl = dir ? 63 - t : t; Od[tl * 68 + 16 * dt + fr] = acc[dt][j]; }
        __syncthreads();
        {
            const int tokl = tid >> 3, d0 = 8 * (tid & 7);
            const int row = isctx ? (ML + b * CTXL + 64 * tcl + tokl) : (b * SEQ + 64 * tcl + tokl);
            float o[8]; float ss = 0.f;
#pragma unroll
            for (int i = 0; i < 8; ++i) { o[i] = Od0[tokl * 68 + d0 + i] + Od1[tokl * 68 + d0 + i]; ss += o[i] * o[i]; }
            ss += __shfl_xor(ss, 1); ss += __shfl_xor(ss, 2); ss += __shfl_xor(ss, 4);
            const float rstd = rsqrtf(ss * (1.0f / 64.0f) + EPS);
            const float* gp = PH + (size_t)row * PHW + 1024 + 64 * h + d0; const float* ng = a->hg_norm_g + l * 256 + 64 * h + d0;
            float y[8];
#pragma unroll
            for (int i = 0; i < 8; ++i) y[i] = o[i] * rstd * ng[i] * gp[i];
            u32x4 w; w.x = pg8::cvt_pk_bf16(y[0], y[1]); w.y = pg8::cvt_pk_bf16(y[2], y[3]); w.z = pg8::cvt_pk_bf16(y[4], y[5]); w.w = pg8::cvt_pk_bf16(y[6], y[7]);
            *(u32x4*)(O + (size_t)row * DM + 64 * h + d0) = w;
        }
        __syncthreads();
    }
}

constexpr int AS = 72;
constexpr int VS = 136;
constexpr float LOG2E = 1.4426950408889634f;
constexpr int CTR_WORD0 = 3584;
__device__ __forceinline__ void phase_attn(ArgsP a, LAS unsigned char* L, int l, bool need_ctx, int tid, int lane, int wave) {
    asm volatile("" : "+s"(a) :: "memory");
    unsigned char* ws = a->ws;
    const bf16* PA = (const bf16*)(ws + WS_PA); const bf16* VT = (const bf16*)(ws + WS_VT); bf16* O = (bf16*)(ws + WS_O);
    LAS bf16* Ks0 = (LAS bf16*)L;
    LAS bf16* Vs0 = Ks0 + 2 * 128 * AS;
    LAS float* rpbl = (LAS float*)(L + 2 * 128 * AS * 2 + 2 * 64 * VS * 2);
    volatile LAS unsigned* slot = (volatile LAS unsigned*)(L + LDS_BYTES - 32);
    unsigned* ctr = (unsigned*)(ws + WS_BAR) + CTR_WORD0 + l;
    const int fr = lane & 15, g = lane >> 4;
    const int srow = tid >> 3, sc8 = 8 * (tid & 7);
    const int kap = ((fr >> 2) << 3) + (fr & 3);
    const int nunits = need_ctx ? 816 : 768;
    for (;;) {
        __syncthreads();
        if (tid == 0) slot[0] = __hip_atomic_fetch_add(ctr, 1u, __ATOMIC_RELAXED, __HIP_MEMORY_SCOPE_AGENT);
        __syncthreads();
        const int unit = (int)slot[0];
        if (unit >= nunits) break;
        int kind, b, h, blk;
        if (unit < 384) { kind = 0; b = unit / 96; h = (unit % 96) >> 4; blk = unit & 15; }
        else if (unit < 768) { const int u = unit - 384; kind = 1; b = u / 96; h = (u % 96) >> 4; blk = u & 15; }
        else if (unit < 792) { const int u = unit - 768; kind = 2; b = u / 6; h = u % 6; blk = 0; }
        else { const int u = unit - 792; kind = 3; b = u / 6; h = u % 6; blk = 0; }
        const bool sw = (kind & 1) != 0, qctx = kind >= 2;
        const int quarter = wave & 3, cs = quarter == 0 ? 0 : quarter == 1 ? 8 : quarter == 2 ? 24 : 32;
        const int qc = 16 * quarter + fr, c0 = min(max(qc - 8, 0), 48);
        int qt[2], rr[2], rs[2], qlo[2];
#pragma unroll
        for (int t = 0; t < 2; ++t) {
            rr[t] = 4 * blk + 2 * (wave >> 2) + t;
            qt[t] = kind == 0 ? rr[t] * 4 + quarter : (kind == 1 ? blk * 16 : 0) + 2 * wave + t;
            rs[t] = min(max(rr[t] - 4, 0), 56); qlo[t] = 16 * qt[t]; }
        const int qbase = qctx ? ML + b * CTXL : b * SEQ;
        const int qcol = sw ? 768 + 64 * h : 64 * h;
        const int kcol = sw ? 1152 + 64 * (h / 3) : 384 + 64 * h;
        const int vh = sw ? 6 + h / 3 : h;
        const int ocol = sw ? 640 + 64 * h : 256 + 64 * h;
        const bf16* vtb = VT + (size_t)((b * 8 + vh) * 64) * VTOK;
        int nlatc = 0, lat0 = 0;
        if (kind == 0) { const int r0 = 4 * blk, rs0 = min(max(r0 - 4, 0), 56), rs3 = min(max(r0 - 1, 0), 56); lat0 = rs0; nlatc = (rs3 - rs0 + 8 + 1) >> 1; }
        else if (kind == 1) { const int ks = max(0, 256 * blk - 128), ke = min(SEQ, 256 * blk + 384); lat0 = ks; nlatc = (ke - ks) >> 7; }
        const int nch = 2 + nlatc;
        if (kind == 0) { const float* rp = a->rpb + (size_t)(l * 6 + h) * 465; for (int i = tid; i < 465; i += 512) rpbl[i] = rp[i] * LOG2E; }
        bf16x8 qf[2][2];
#pragma unroll
        for (int t = 0; t < 2; ++t)
#pragma unroll
            for (int ks = 0; ks < 2; ++ks) qf[t][ks] = *(const bf16x8*)(PA + (size_t)(qbase + qlo[t] + fr) * PAW + qcol + 32 * ks + 8 * g);
        float m_run[2], l_run[2]; f32x4 acc[2][4];
#pragma unroll
        for (int t = 0; t < 2; ++t) { m_run[t] = sw ? a->sink[l * 6 + h] * LOG2E : -1e30f; l_run[t] = (sw && g == 0) ? 1.0f : 0.f;
#pragma unroll
            for (int dt = 0; dt < 4; ++dt) acc[t][dt] = (f32x4){0.f, 0.f, 0.f, 0.f}; }
#define CHUNK_LOAD(c_, K0, K1, V0, V1) do { const int cc_ = (c_); int krow, vtok; \
            if (cc_ < 2) { krow = ML + b * CTXL + 128 * cc_; vtok = SEQ + 128 * cc_; } \
            else if (kind == 0) { const int kk_ = 64 * (lat0 + 2 * (cc_ - 2)); krow = b * SEQ + kk_; vtok = kk_; } \
            else { const int kk_ = lat0 + 128 * (cc_ - 2); krow = b * SEQ + kk_; vtok = kk_; } \
            K0 = *(const bf16x8*)(PA + (size_t)(krow + srow) * PAW + kcol + sc8); K1 = *(const bf16x8*)(PA + (size_t)(krow + 64 + srow) * PAW + kcol + sc8); \
            V0 = *(const bf16x8*)(vtb + (size_t)srow * VTOK + vtok + sc8); V1 = *(const bf16x8*)(vtb + (size_t)srow * VTOK + vtok + 64 + sc8); } while (0)
        bf16x8 ka0, ka1, va0, va1, kb0, kb1, vb0, vb1;
        CHUNK_LOAD(0, ka0, ka1, va0, va1); CHUNK_LOAD(1, kb0, kb1, vb0, vb1);
        auto chunk_compute = [&](const int c) __attribute__((always_inline)) {
            LAS bf16* Ks = Ks0 + (c & 1) * 128 * AS; LAS bf16* Vs = Vs0 + (c & 1) * 64 * VS;
            for (int pp = 0; pp < 2; ++pp) {
                int ko0, ko1, mode = 0; int x0[2] = {0, 0}, x1[2] = {0, 0};
                if (c < 2) { ko0 = 64 * pp; ko1 = ko0 + 32; }
                else if (kind == 0) { if (pp == 1) continue; const int kr = lat0 + 2 * (c - 2); bool any = false;
#pragma unroll
                    for (int t = 0; t < 2; ++t) { const bool v0 = kr >= rs[t] && kr < rs[t] + 8, v1 = kr + 1 >= rs[t] && kr + 1 < rs[t] + 8; any = any || v0 || v1; x0[t] = v0 ? kr - rr[t] + 7 : -1; x1[t] = v1 ? kr + 1 - rr[t] + 7 : -1; }
                    if (!any) continue; ko0 = cs; ko1 = 64 + cs; mode = 1; }
                else { const int kp = lat0 + 128 * (c - 2) + 64 * pp; if (kp + 63 < qlo[0] - 128 || kp > qlo[1] + 15 + 128) continue; ko0 = 64 * pp; ko1 = ko0 + 32; mode = 2; x0[0] = x0[1] = kp; x1[0] = x1[1] = kp + 32; }
                bf16x8 kfr[4][2];
#pragma unroll
                for (int mm = 0; mm < 4; ++mm) { const int ko = (mm < 2 ? ko0 : ko1) + kap + 4 * (mm & 1);
#pragma unroll
                    for (int ks = 0; ks < 2; ++ks) kfr[mm][ks] = *(const LAS bf16x8*)(Ks + ko * AS + 32 * ks + 8 * g); }
#pragma unroll
                for (int t = 0; t < 2; ++t) {
                    f32x4 cacc[4];
#pragma unroll
                    for (int mm = 0; mm < 4; ++mm) { cacc[mm] = (f32x4){0.f, 0.f, 0.f, 0.f};
#pragma unroll
                        for (int ks = 0; ks < 2; ++ks) cacc[mm] = __builtin_amdgcn_mfma_f32_16x16x32_bf16(kfr[mm][ks], qf[t][ks], cacc[mm], 0, 0, 0); }
                    float s[16];
#pragma unroll
                    for (int e = 0; e < 16; ++e) s[e] = cacc[e >> 2][e & 3];
                    if (mode == 1) {
                        float bv[16]; bool okv[16];
#pragma unroll
                        for (int hh = 0; hh < 2; ++hh) { const int xr = hh ? x1[t] : x0[t]; const LAS float* rp = rpbl + max(xr, 0) * 31 + 15 - qc;
#pragma unroll
                            for (int e = 0; e < 8; ++e) { const int kc = cs + 8 * g + e; const bool ok = xr >= 0 && kc >= c0 && kc < c0 + 16; okv[8 * hh + e] = ok; bv[8 * hh + e] = rp[min(max(kc, c0), c0 + 15)]; } }
#pragma unroll
                        for (int e = 0; e < 16; ++e) s[e] = okv[e] ? s[e] + bv[e] : -1e30f; }
                    else if (mode == 2) { const int qpos = qlo[t] + fr;
#pragma unroll
                        for (int hh = 0; hh < 2; ++hh) { const int kp = (hh ? x1[t] : x0[t]) + 8 * g;
#pragma unroll
                            for (int e = 0; e < 8; ++e) { const int d = qpos - (kp + e); s[8 * hh + e] = (d <= 128 && d >= -128) ? s[8 * hh + e] : -1e30f; } } }
                    float tm = s[0];
#pragma unroll
                    for (int e = 1; e < 16; ++e) tm = fmaxf(tm, s[e]);
                    tm = xmax32(xmax16(tm));
                    const float m_new = fmaxf(m_run[t], tm), alpha = __builtin_amdgcn_exp2f(m_run[t] - m_new);
                    float p[16], ps = 0.f;
#pragma unroll
                    for (int e = 0; e < 16; ++e) { p[e] = __builtin_amdgcn_exp2f(s[e] - m_new); ps += p[e]; }
                    l_run[t] = l_run[t] * alpha + ps; m_run[t] = m_new;
                    u32x4 pu0, pu1;
                    pu0.x = pg8::cvt_pk_bf16(p[0], p[1]); pu0.y = pg8::cvt_pk_bf16(p[2], p[3]); pu0.z = pg8::cvt_pk_bf16(p[4], p[5]); pu0.w = pg8::cvt_pk_bf16(p[6], p[7]);
                    pu1.x = pg8::cvt_pk_bf16(p[8], p[9]); pu1.y = pg8::cvt_pk_bf16(p[10], p[11]); pu1.z = pg8::cvt_pk_bf16(p[12], p[13]); pu1.w = pg8::cvt_pk_bf16(p[14], p[15]);
                    const bf16x8 pb0 = __builtin_bit_cast(bf16x8, pu0), pb1 = __builtin_bit_cast(bf16x8, pu1);
#pragma unroll
                    for (int dt = 0; dt < 4; ++dt) { acc[t][dt] = acc[t][dt] * alpha;
                        acc[t][dt] = __builtin_amdgcn_mfma_f32_16x16x32_bf16(*(const LAS bf16x8*)(Vs + (16 * dt + fr) * VS + ko0 + 8 * g), pb0, acc[t][dt], 0, 0, 0);
                        acc[t][dt] = __builtin_amdgcn_mfma_f32_16x16x32_bf16(*(const LAS bf16x8*)(Vs + (16 * dt + fr) * VS + ko1 + 8 * g), pb1, acc[t][dt], 0, 0, 0); }
                }
            }
        };
#define CHUNK_STEP(c_, K0, K1, V0, V1) do { const int cs_ = (c_); if (cs_ < nch) { \
            LAS bf16* kd_ = Ks0 + (cs_ & 1) * 128 * AS + srow * AS + sc8; LAS bf16* vd_ = Vs0 + (cs_ & 1) * 64 * VS + srow * VS + sc8; \
            *(LAS bf16x8*)kd_ = K0; *(LAS bf16x8*)(kd_ + 64 * AS) = K1; *(LAS bf16x8*)vd_ = V0; *(LAS bf16x8*)(vd_ + 64) = V1; \
            if (cs_ + 2 < nch) CHUNK_LOAD(cs_ + 2, K0, K1, V0, V1); \
            __syncthreads(); chunk_compute(cs_); } } while (0)
        for (int c = 0; c < nch; c += 2) { CHUNK_STEP(c, ka0, ka1, va0, va1); CHUNK_STEP(c + 1, kb0, kb1, vb0, vb1); }
#undef CHUNK_STEP
#undef CHUNK_LOAD
#pragma unroll
        for (int t = 0; t < 2; ++t) {
            const float lt = xsum32(xsum16(l_run[t])), inv = 1.0f / lt;
            bf16* op = O + (size_t)(qbase + qlo[t] + fr) * DM + ocol + 4 * g;
#pragma unroll
            for (int dt = 0; dt < 4; ++dt) { const f32x4 v = acc[t][dt] * inv; u32x2 w; w.x = pg8::cvt_pk_bf16(v[0], v[1]); w.y = pg8::cvt_pk_bf16(v[2], v[3]); *(u32x2*)(op + 16 * dt) = w; } }
    }
}

#define XB_TMO      128
#define XB_XCNT(j)  (256  + 64 * (j))
#define XB_XSUB(j)  (1280 + 64 * (j))
#define XB_XGEN(j)  (2304 + 64 * (j))
#define XB_TOP      3328
#define XB_TOPGEN   3392
#define XCD_BAR_WORDS 3456
#define XB_SPIN_CAP (1u << 18)

__device__ __forceinline__ unsigned xb_ld(unsigned* p)              { return __hip_atomic_load(p, __ATOMIC_RELAXED, __HIP_MEMORY_SCOPE_AGENT); }
__device__ __forceinline__ unsigned xb_add(unsigned* p, unsigned v) { return __hip_atomic_fetch_add(p, v, __ATOMIC_RELAXED, __HIP_MEMORY_SCOPE_AGENT); }
__device__ __forceinline__ unsigned xb_xcc_id() { return (unsigned)__builtin_amdgcn_s_getreg((3 << 11) | 20) & 0xFu; }
#define XB_SPIN(cond, bar) do { unsigned _sp = 0; while (cond) { __builtin_amdgcn_s_sleep(1); \
    if ((++_sp & 255u) == 0u) { if (xb_ld(&(bar)[XB_TMO])) break; if (_sp > XB_SPIN_CAP) { atomicAdd(&(bar)[XB_TMO], 1u); break; } } } } while (0)

struct XcdBarrier {
    unsigned* bar; unsigned x;
    volatile LAS unsigned* st;
};

__device__ __forceinline__ XcdBarrier xcd_barrier_post(unsigned* bar, volatile LAS unsigned* st) {
    XcdBarrier b; b.bar = bar; b.x = xb_xcc_id(); b.st = st;
    if (threadIdx.x == 0) (void)xb_add(&bar[XB_XCNT(b.x)], 1u);
    return b;
}
__device__ __forceinline__ void xcd_barrier_complete(unsigned* bar, unsigned x, unsigned& nloc, unsigned& nx) {
    const unsigned G = gridDim.x * gridDim.y * gridDim.z;
    unsigned sum, cnt, mine, sp = 0u;
    for (;;) {
        sum = 0u; cnt = 0u; mine = 0u;
#pragma unroll
        for (unsigned j = 0; j < 16; ++j) { const unsigned c = xb_ld(&bar[XB_XCNT(j)]); sum += c; cnt += (c > 0u) ? 1u : 0u; mine = (j == x) ? c : mine; }
        if (sum == G) break;
        __builtin_amdgcn_s_sleep(1);
        if ((++sp & 255u) == 0u) { if (xb_ld(&bar[XB_TMO])) break; if (sp > XB_SPIN_CAP) { atomicAdd(&bar[XB_TMO], 1u); break; } }
    }
    nloc = mine > 0u ? mine : 1u; nx = cnt > 0u ? cnt : 1u;
}

__device__ __forceinline__ void xcd_barrier(const XcdBarrier& b) {
    asm volatile("s_waitcnt vmcnt(0)" ::: "memory");
    __syncthreads();
    if (threadIdx.x == 0) {
        unsigned* bar = b.bar;
        __builtin_amdgcn_s_waitcnt(0);
        unsigned nloc = b.st[0], nx = b.st[1];
        if (nloc == 0u) { xcd_barrier_complete(bar, b.x, nloc, nx); b.st[0] = nloc; b.st[1] = nx; }
        const unsigned old = xb_add(&bar[XB_XSUB(b.x)], 1u);
        const unsigned gen = old / nloc;
        if (old + 1u == (gen + 1u) * nloc) {
            __builtin_amdgcn_fence(__ATOMIC_RELEASE, "agent");
            asm volatile("s_waitcnt vmcnt(0)" ::: "memory");
            const unsigned og = xb_add(&bar[XB_TOP], 1u);
            const unsigned tg = og / nx;
            if (og + 1u == (tg + 1u) * nx) xb_add(&bar[XB_TOPGEN], 1u);
            else XB_SPIN(xb_ld(&bar[XB_TOPGEN]) == tg, bar);
            __builtin_amdgcn_fence(__ATOMIC_ACQUIRE, "agent");
            xb_add(&bar[XB_XGEN(b.x)], 1u);
            asm volatile("s_waitcnt vmcnt(0)" ::: "memory");
        } else {
            XB_SPIN(xb_ld(&bar[XB_XGEN(b.x)]) == gen, bar);
            __builtin_amdgcn_fence(__ATOMIC_ACQUIRE, "agent");
            asm volatile("s_waitcnt vmcnt(0)" ::: "memory");
        }
    }
    __syncthreads();
}

__global__ void __launch_bounds__(512, 2) mk_fwd(Args a_unused) {
    extern __shared__ __attribute__((aligned(16))) unsigned char lds_raw[];
    LAS unsigned char* L = (LAS unsigned char*)lds_raw;
    cg::grid_group grid = cg::this_grid();
    volatile LAS unsigned* bst = (volatile LAS unsigned*)(L + LDS_BYTES - 64);
    if (threadIdx.x < 2) bst[threadIdx.x] = 0u;
    __syncthreads();
    ArgsP a0 = (ArgsP)__builtin_amdgcn_kernarg_segment_ptr();
    const int ph_hi = a0->ph_hi;
    XcdBarrier xbar = xcd_barrier_post((unsigned*)(a0->ws + WS_BAR), bst);
    for (int ph = a0->ph_lo; ph < ph_hi; ++ph) {
        ArgsP a = a0; asm volatile("" : "+s"(a) :: "memory");
        int tid = threadIdx.x; asm volatile("" : "+v"(tid));
        const int lane = tid & 63, wave = __builtin_amdgcn_readfirstlane(tid >> 6);
#ifndef PMASK
#define PMASK 0xFFFF
#endif
        if ((PMASK & 1) && ph == 0) phase_prologue(a, L, tid, lane, wave);
        else if ((PMASK & 2) && ph == NPHASE - 1) phase_final(a, lane, wave);
        else {
            const int l = (ph - 1) / 12, k = (ph - 1) % 12;
            const bool need_ctx = l < DEPTH - 1;
            if ((PMASK & 4) && (k == 0 || k == 3 || k == 9)) { const int sub = k == 0 ? 0 : k == 3 ? 1 : 2; const int nsp = sub == 1 ? 6 : sub == 2 ? (need_ctx ? 4 : 0) : (l > 0 ? 6 : 0); phase_norm(a, l, sub, (sub == 2 && !need_ctx) ? ML : MT, nsp, lane, wave); }
            else if ((PMASK & 8) && (k == 1 || k == 10 || k == 2 || k == 8 || k == 11 || k == 4)) {
                unsigned char* ws = a->ws; asm volatile("" : "+s"(ws) :: "memory");
                const bf16* A; const bf16* Bt; int Mr = MT, N, K; EpiAll E{ws, 0, l, 0, 0.5f, 0, 1}; int ntsplit = 0;
                if (k == 1 || k == 10) { const int s = k == 1 ? 0 : 1; if (s == 1 && !need_ctx) Mr = ML; A = (const bf16*)(ws + WS_XN); Bt = w13p(ws, l, s); N = 2 * FF; K = DM; E.mode = 0; }
                else if (k == 4) { A = (const bf16*)(ws + WS_XN); Bt = winp(ws, l); N = INW; K = DM; E.mode = 2; }
                else { E.mode = 1; N = DM; if (k != 2 && !need_ctx) Mr = ML;
                    ntsplit = (k == 8) ? 4 : 8;
                    if (k == 2) { A = (const bf16*)(ws + WS_U); Bt = w2p(ws, l, 0); K = FF; E.gi = 2; }
                    else if (k == 8) { A = (const bf16*)(ws + WS_O); Bt = woutp(ws, l); K = DM; E.coef = 1.0f; E.gi = 5; }
                    else { A = (const bf16*)(ws + WS_U); Bt = w2p(ws, l, 1); K = FF; E.gi = 8; } }
                E.ntfull = K / 64; E.ntsplit = ntsplit > 0 ? ntsplit : 1;
                pg8::Gemm gm{A, Bt, Mr, N, K}; pg8::StaticOrder S; S.init(Mr, N, K, gridDim.x, blockIdx.x, ntsplit);
                pg8::gemm_phase<EpiAll, pg8::StaticOrder, true, true>(L, gm, S, E); }
            else if ((PMASK & 64) && k == 5) phase_h1(a, L, tid, lane, wave);
            else if ((PMASK & 128) && k == 6) phase_h2(a, tid);
            else if (k == 7) { if (PMASK & 256) phase_h3(a, L, l, need_ctx, tid, lane, wave); if (PMASK & 512) phase_attn(a, L, l, need_ctx, tid, lane, wave); }
        }
        if (ph + 1 < ph_hi) { if (ph == 0) grid.sync(); else xcd_barrier(xbar); }
    }
}

extern "C" void kernel_launch(void* const* d_in, const int* in_sizes, int n_in, void* d_out, int out_size, void* d_ws, size_t ws_size, hipStream_t stream) {
    static int grid = 0;
    if (grid == 0) {
        if (n_in != 17 || out_size != ML * DM || ws_size < WS_END) { fprintf(stderr, "kernel_launch: unexpected shapes (n_in %d out %d ws %zu need %zu)\n", n_in, out_size, ws_size, (size_t)WS_END); grid = -1; return; }
        int dev = 0, cus = 0, per_cu = 0;
        hipGetDevice(&dev); hipDeviceGetAttribute(&cus, hipDeviceAttributeMultiprocessorCount, dev);
        if (hipFuncSetAttribute((const void*)mk_fwd, hipFuncAttributeMaxDynamicSharedMemorySize, LDS_BYTES) != hipSuccess) { fprintf(stderr, "kernel_launch: hipFuncSetAttribute failed\n"); grid = -1; return; }
        if (hipOccupancyMaxActiveBlocksPerMultiprocessor(&per_cu, (const void*)mk_fwd, 512, LDS_BYTES) != hipSuccess || per_cu < 1) { fprintf(stderr, "kernel_launch: occupancy query says %d\n", per_cu); per_cu = 1; }
        (void)hipGetLastError();
        grid = cus * per_cu;
        fprintf(stderr, "kernel_launch: grid %d (cus %d x %d)\n", grid, cus, per_cu);
    }
    if (grid < 0) return;
    Args a{};
    a.x = (const float*)d_in[0]; a.c = (const float*)d_in[1]; a.ctx = (const float*)d_in[2]; a.c_ctx = (const float*)d_in[3]; a.ada_w = (const float*)d_in[4]; a.ada_b = (const float*)d_in[5];
    a.norm_g = (const float*)d_in[6]; a.w1 = (const float*)d_in[7]; a.w3 = (const float*)d_in[8]; a.w2 = (const float*)d_in[9]; a.w_in = (const float*)d_in[10]; a.w_out = (const float*)d_in[11];
    a.lb_logits = (const float*)d_in[12]; a.hg_norm_g = (const float*)d_in[13]; a.rpb = (const float*)d_in[14]; a.sink = (const float*)d_in[15]; a.final_g = (const float*)d_in[16];
    a.out = (float*)d_out; a.ws = (unsigned char*)d_ws;
#if ONE_LAUNCH
    if (hipMemsetAsync((unsigned char*)d_ws + WS_BAR, 0, BAR_BYTES, stream) != hipSuccess) { fprintf(stderr, "kernel_launch: memset failed\n"); return; }
    a.ph_lo = 0; a.ph_hi = NPHASE;
    void* args[] = {&a};
    hipError_t e = hipLaunchCooperativeKernel((const void*)mk_fwd, dim3(grid), dim3(512), args, LDS_BYTES, stream);
    if (e != hipSuccess) fprintf(stderr, "cooperative launch failed: %s (grid %d)\n", hipGetErrorString(e), grid);
#else
    for (int ph = 0; ph < NPHASE; ++ph) { a.ph_lo = ph; a.ph_hi = ph + 1; hipLaunchKernelGGL(mk_fwd, dim3(grid), dim3(512), LDS_BYTES, stream, a); }
#endif
}
```

```cpp
#include <hip/hip_runtime.h>
#include <hip/hip_cooperative_groups.h>
#include <cstdio>
#include <cstdint>
namespace cg = cooperative_groups;
#ifndef ONE_LAUNCH
#define ONE_LAUNCH 1
#endif
namespace pg8 {
#define PG8_LAS __attribute__((address_space(3)))
typedef unsigned short bf16_t;
typedef short bf16x8 __attribute__((ext_vector_type(8)));
typedef float f32x4 __attribute__((ext_vector_type(4)));
typedef unsigned u32x4 __attribute__((ext_vector_type(4)));
constexpr int BM = 256, BK = 64, HALF = 128, HTB = HALF * BK * 2  , STAGE_BYTES = 8 * HTB, NXCD = 8, WGM = 8;

__host__ __device__ __forceinline__ int lds_byte(int r, int c) { const int st = (r >> 4) * 2 + (c >> 5), rr = r & 15, cc = c & 31, ob = rr * 64 + cc * 2; return st * 1024 + (ob ^ (((ob >> 9) & 1) << 5)); }
__host__ __device__ __forceinline__ void stage_rc(int b, int& R, int& C) { const int st = b / 1024, sb = b % 1024, swz = sb ^ (((sb >> 9) & 1) << 5); R = (st >> 1) * 16 + swz / 64; C = (st & 1) * 32 + (swz % 64) / 2; }
__host__ __device__ __forceinline__ int perm32(int rho) { const int n = rho >> 4, i = rho & 15; return 8 * (i >> 2) + 4 * n + (i & 3); }

struct Unit { int pm, pn, k0, nt; };
struct Gemm { const bf16_t* A; const bf16_t* Bt; int M, N, K; };

struct StaticOrder {
    int nM, nN, nwg, G, c, ntK, nsplit, ntsplit, nsmall;
    __host__ __device__ void init(int M, int N, int K, int G_, int c_, int ntsplit_ = 0) { nM = M / BM; nN = N / BM; G = G_; c = c_; ntK = K / BK; ntsplit = ntsplit_; nsplit = 0; nsmall = 0;
        if (ntsplit > 0 && nM > 64) { nsplit = (ntK + ntsplit - 1) / ntsplit; nsmall = (nM - 64) * nN * nsplit; nM = 64; } nwg = nM * nN; }
    __host__ __device__ __forceinline__ bool next(int i, Unit& u) const {
        const long L = (long)i * G + c; if (L >= nwg + nsmall) return false;
        const bool small = L >= nwg;
        const int j = small ? (int)L - nwg : 0, dv = nsplit > 0 ? nsplit : 1, tile = j / dv, sp = j - tile * dv;
        const int rem = ntK - sp * ntsplit, s_pm = 64 + tile / nN, s_pn = tile % nN, s_k0 = sp * ntsplit * BK, s_nt = rem < ntsplit ? rem : ntsplit;
        int wgid = small ? 0 : (int)L; { const int q = nwg / NXCD, r = nwg % NXCD, xcd = wgid % NXCD, off = wgid / NXCD; wgid = (xcd < r ? xcd * (q + 1) : r * (q + 1) + (xcd - r) * q) + off; }
        const int nig = WGM * nN, gid = wgid / nig, fm = gid * WGM, gsz = (nM - fm) < WGM ? (nM - fm) : WGM;
        const int f_pm = fm + ((wgid % nig) % gsz), f_pn = (wgid % nig) / gsz;
        Unit r_; r_.pm = small ? s_pm : f_pm; r_.pn = small ? s_pn : f_pn; r_.k0 = small ? s_k0 : 0; r_.nt = small ? s_nt : ntK; u = r_; return true;
    }
    __device__ __forceinline__ void a_ready(const Unit&) const {}
    __device__ __forceinline__ void done(const Unit&) const {}
};

typedef float cvt_f32x2 __attribute__((ext_vector_type(2)));
typedef __bf16 cvt_bf16x2 __attribute__((ext_vector_type(2)));
__device__ __forceinline__ unsigned cvt_pk_bf16(float lo, float hi) { const cvt_f32x2 v = {lo, hi}; const cvt_bf16x2 r = __builtin_convertvector(v, cvt_bf16x2); return __builtin_bit_cast(unsigned, r); }
typedef float f32x2 __attribute__((ext_vector_type(2)));
template <class Epi, class Sched, bool ALIGN_EPI = false, bool SP2 = false>
__device__ __forceinline__ void gemm_phase(PG8_LAS unsigned char* lds, const Gemm g, const Sched& S, const Epi& E) {
    int tid = threadIdx.x; asm volatile("" : "+v"(tid));
    const int wid = __builtin_amdgcn_readfirstlane(tid >> 6), lane = tid & 63, wr = wid >> 2, wc = wid & 3, fr = lane & 15, fq = lane >> 4;
    const int K = g.K;
    unsigned voffA[2], voffB[2];
#pragma unroll
    for (int i = 0; i < 2; ++i) { int R, C; stage_rc(tid * 16 + i * 8192, R, C); const int Rb = Epi::PERM ? ((R & ~31) + perm32(R & 31)) : R;
        voffA[i] = (unsigned)(R * K + C) * 2u; voffB[i] = (unsigned)(Rb * K + C) * 2u; }
    const size_t kstep = (size_t)(BK * 2);
    const size_t hstep = (size_t)HALF * K * 2;
    const size_t tstep = 2 * hstep;
    const unsigned ldsw = (unsigned)wid * 1024u;
    const int aoff = lds_byte(wr * 64 + fr, fq * 8), boff = lds_byte(wc * 32 + fr, fq * 8);
#define PG8_SA(b, h) (((b) * 2 + (h)) * HTB)
#define PG8_SB(b, h) ((4 + (b) * 2 + (h)) * HTB)
#define PG8_STAGE(bufoff, gbase, voff) do { _Pragma("unroll") for (int _i = 0; _i < 2; ++_i) \
        __builtin_amdgcn_global_load_lds((const unsigned*)((const char*)(gbase) + (voff)[_i]), (PG8_LAS unsigned*)(lds + (bufoff) + ldsw + _i * 8192), 16, 0, 0); } while (0)
#define PG8_LDA(dst, b, h) do { _Pragma("unroll") for (int m = 0; m < 4; ++m) _Pragma("unroll") for (int k = 0; k < 2; ++k) dst[m][k] = *(const PG8_LAS bf16x8*)(lds + PG8_SA(b, h) + aoff + m * 2048 + k * 1024); } while (0)
#define PG8_LDB(dst, b, h) do { _Pragma("unroll") for (int n = 0; n < 2; ++n) _Pragma("unroll") for (int k = 0; k < 2; ++k) dst[n][k] = *(const PG8_LAS bf16x8*)(lds + PG8_SB(b, h) + boff + n * 2048 + k * 1024); } while (0)
#define PG8_MMA(ai, bj, At, Bt) do { __builtin_amdgcn_s_setprio(1); _Pragma("unroll") for (int m = 0; m < 4; ++m) _Pragma("unroll") for (int n = 0; n < 2; ++n) _Pragma("unroll") for (int k = 0; k < 2; ++k) \
        acc[ai][bj][m][n] = __builtin_amdgcn_mfma_f32_16x16x32_bf16(Bt[n][k], At[m][k], acc[ai][bj][m][n], 0, 0, 0); __builtin_amdgcn_s_setprio(0); } while (0)
#define PG8_WAIT_V(n) asm volatile("s_waitcnt vmcnt(" #n ")" ::: "memory")
#define PG8_WAIT_L(n) asm volatile("s_waitcnt lgkmcnt(" #n ")" ::: "memory")
#define PG8_BAR __builtin_amdgcn_s_barrier()
#define PG8_SCHED __builtin_amdgcn_sched_barrier(0)
    Unit cur, nxt; int ui = 0;
    if (!S.next(0, cur)) return;
    f32x4 acc[2][2][4][2];
#pragma unroll
    for (int a = 0; a < 2; ++a)
#pragma unroll
        for (int b = 0; b < 2; ++b)
#pragma unroll
            for (int m = 0; m < 4; ++m)
#pragma unroll
                for (int n = 0; n < 2; ++n) acc[a][b][m][n] = (f32x4){0.f, 0.f, 0.f, 0.f};
    bf16x8 At[4][2], B0[2][2], B1[2][2];
    const char* cA = (const char*)g.A + (size_t)cur.pm * tstep + (size_t)cur.k0 * 2; const char* cB = (const char*)g.Bt + (size_t)cur.pn * tstep + (size_t)cur.k0 * 2;
    S.a_ready(cur);
    if constexpr (SP2) {
        PG8_STAGE(PG8_SB(0, 0), cB, voffB); PG8_STAGE(PG8_SB(0, 1), cB + hstep, voffB); PG8_STAGE(PG8_SA(0, 0), cA, voffA); PG8_STAGE(PG8_SA(0, 1), cA + hstep, voffA);
        if (wr == 1) PG8_BAR;
        PG8_WAIT_V(2); PG8_BAR;
        PG8_STAGE(PG8_SB(1, 0), cB + kstep, voffB); PG8_STAGE(PG8_SA(1, 0), cA + kstep, voffA); PG8_STAGE(PG8_SB(1, 1), cB + hstep + kstep, voffB);
        PG8_WAIT_V(6); PG8_BAR;
    } else {
        PG8_STAGE(PG8_SB(0, 0), cB, voffB); PG8_STAGE(PG8_SA(0, 0), cA, voffA); PG8_STAGE(PG8_SB(0, 1), cB + hstep, voffB); PG8_STAGE(PG8_SA(0, 1), cA + hstep, voffA);
        if (wr == 1) PG8_BAR;
        PG8_WAIT_V(4); PG8_BAR;
        PG8_STAGE(PG8_SB(1, 0), cB + kstep, voffB); PG8_STAGE(PG8_SA(1, 0), cA + kstep, voffA); PG8_STAGE(PG8_SB(1, 1), cB + hstep + kstep, voffB);
        PG8_WAIT_V(6); PG8_BAR;
    }
    for (;;) {
        const bool has_next = S.next(ui + 1, nxt);
        const char* nA = has_next ? (const char*)g.A + (size_t)nxt.pm * tstep + (size_t)nxt.k0 * 2 : cA; const char* nB = has_next ? (const char*)g.Bt + (size_t)nxt.pn * tstep + (size_t)nxt.k0 * 2 : cB;
        const int nt = cur.nt;
        for (int t = 0; t < nt; t += 2) {
            const bool last = (t == nt - 2);
            const char* a1 = cA + (size_t)(t + 1) * kstep;
            const char* a2 = last ? nA : cA + (size_t)(t + 2) * kstep; const char* b2 = last ? nB : cB + (size_t)(t + 2) * kstep;
            const char* a3 = a2 + kstep; const char* b3 = b2 + kstep;
            if (last && has_next) S.a_ready(nxt);
            if constexpr (SP2) {
            PG8_LDB(B0, 0, 0); PG8_LDB(B1, 0, 1); PG8_SCHED; PG8_LDA(At, 0, 0); PG8_STAGE(PG8_SA(1, 1), a1 + hstep, voffA);
            PG8_WAIT_V(8); PG8_WAIT_L(0); PG8_BAR; PG8_MMA(0, 0, At, B0); PG8_MMA(0, 1, At, B1); PG8_BAR; PG8_SCHED;
            PG8_LDA(At, 0, 1); PG8_STAGE(PG8_SB(0, 0), b2, voffB); PG8_STAGE(PG8_SB(0, 1), b2 + hstep, voffB); PG8_STAGE(PG8_SA(0, 0), a2, voffA);
            PG8_WAIT_V(8); PG8_WAIT_L(0); PG8_BAR; PG8_MMA(1, 0, At, B0); PG8_MMA(1, 1, At, B1); PG8_BAR; PG8_SCHED;
            PG8_LDB(B0, 1, 0); PG8_LDB(B1, 1, 1); PG8_SCHED; PG8_LDA(At, 1, 0); PG8_STAGE(PG8_SA(0, 1), a2 + hstep, voffA);
            PG8_WAIT_V(8); PG8_WAIT_L(0); PG8_BAR; PG8_MMA(0, 0, At, B0); PG8_MMA(0, 1, At, B1); PG8_BAR; PG8_SCHED;
            PG8_LDA(At, 1, 1); PG8_STAGE(PG8_SB(1, 0), b3, voffB); PG8_STAGE(PG8_SB(1, 1), b3 + hstep, voffB); PG8_STAGE(PG8_SA(1, 0), a3, voffA);
            PG8_WAIT_V(8); PG8_WAIT_L(0); PG8_BAR; PG8_MMA(1, 0, At, B0); PG8_MMA(1, 1, At, B1); PG8_BAR; PG8_SCHED;
            } else {
            PG8_LDB(B0, 0, 0); PG8_SCHED; PG8_LDA(At, 0, 0); PG8_STAGE(PG8_SA(1, 1), a1 + hstep, voffA);
            PG8_WAIT_L(8); PG8_BAR; PG8_WAIT_L(0); PG8_MMA(0, 0, At, B0); PG8_BAR; PG8_SCHED;
            PG8_LDB(B1, 0, 1); PG8_STAGE(PG8_SB(0, 0), b2, voffB);
            PG8_BAR; PG8_WAIT_L(0); PG8_MMA(0, 1, At, B1); PG8_BAR;
            PG8_LDA(At, 0, 1); PG8_STAGE(PG8_SA(0, 0), a2, voffA);
            PG8_BAR; PG8_WAIT_L(0); PG8_MMA(1, 0, At, B0); PG8_BAR; PG8_SCHED;
            PG8_STAGE(PG8_SB(0, 1), b2 + hstep, voffB);
            PG8_WAIT_V(6); PG8_BAR; PG8_MMA(1, 1, At, B1); PG8_BAR;
            PG8_LDB(B0, 1, 0); PG8_SCHED; PG8_LDA(At, 1, 0); PG8_STAGE(PG8_SA(0, 1), a2 + hstep, voffA);
            PG8_WAIT_L(8); PG8_BAR; PG8_WAIT_L(0); PG8_MMA(0, 0, At, B0); PG8_BAR; PG8_SCHED;
            PG8_LDB(B1, 1, 1); PG8_STAGE(PG8_SB(1, 0), b3, voffB);
            PG8_BAR; PG8_WAIT_L(0); PG8_MMA(0, 1, At, B1); PG8_BAR;
            PG8_LDA(At, 1, 1); PG8_STAGE(PG8_SA(1, 0), a3, voffA);
            PG8_BAR; PG8_WAIT_L(0); PG8_MMA(1, 0, At, B0); PG8_BAR; PG8_SCHED;
            PG8_STAGE(PG8_SB(1, 1), b3 + hstep, voffB);
            PG8_WAIT_V(6); PG8_BAR; PG8_MMA(1, 1, At, B1); PG8_BAR;
            }
        }
        if constexpr (ALIGN_EPI) { if (wr == 0) PG8_BAR; }
        if constexpr (!Epi::AFTER_DRAIN) { E(acc, cur, wr, wc, fr, fq); S.done(cur); }
        if (!has_next) break;
#pragma unroll
        for (int a = 0; a < 2; ++a)
#pragma unroll
            for (int b = 0; b < 2; ++b)
#pragma unroll
                for (int m = 0; m < 4; ++m)
#pragma unroll
                    for (int n = 0; n < 2; ++n) acc[a][b][m][n] = (f32x4){0.f, 0.f, 0.f, 0.f};
        cur = nxt; cA = nA; cB = nB; ++ui;
        if constexpr (ALIGN_EPI) { if (wr == 1) PG8_BAR; }
    }
    PG8_WAIT_V(0);
    if constexpr (!ALIGN_EPI) { if (wr == 0) PG8_BAR; }
    PG8_BAR;
    if constexpr (Epi::AFTER_DRAIN) { E.fused(acc, cur, wr, wc, fr, fq, lds, wid, lane); S.done(cur); }
#undef PG8_SA
#undef PG8_SB
#undef PG8_STAGE
#undef PG8_LDA
#undef PG8_LDB
#undef PG8_MMA
#undef PG8_WAIT_V
#undef PG8_WAIT_L
#undef PG8_BAR
#undef PG8_SCHED
}
}

#define LAS __attribute__((address_space(3)))
typedef unsigned short bf16;
typedef pg8::bf16x8 bf16x8;
typedef pg8::f32x4 f32x4;
typedef pg8::u32x4 u32x4;
typedef unsigned u32x2 __attribute__((ext_vector_type(2)));

constexpr int DM = 1024, NB = 4, SEQ = 4096, DEPTH = 4, CTXL = 256, FF = 2816, INW = 3072;
constexpr int ML = NB * SEQ, MC = NB * CTXL, MT = ML + MC;
constexpr int NMODV = 9 * DM;
constexpr int PHW = 1280, PAW = 1280, VTOK = SEQ + CTXL;
constexpr int NCH = 68;
constexpr int NHU = NB * 4 * 2 * NCH;
constexpr float EPS = 1e-6f;

constexpr size_t MiB = 1u << 20;
constexpr size_t WS_BAR = 1 * MiB + 32768, BAR_BYTES = 16384;
constexpr size_t WS_MODV = 0, WS_LB = 1 * MiB, WS_ROPE = 1 * MiB + 65536, WS_DEC = 1 * MiB + 131072;
constexpr size_t WS_X = 2 * MiB, WS_XN = 70 * MiB, WS_O = 104 * MiB, WS_U = 138 * MiB, WS_PH = WS_U, WS_PA = 232 * MiB, WS_VT = 275 * MiB, WS_SLOC = 292 * MiB, WS_W = 326 * MiB;
constexpr size_t W13_E = (size_t)2 * FF * DM, W2_E = (size_t)DM * FF, WIN_E = (size_t)INW * DM, WOUT_E = (size_t)DM * DM;
constexpr size_t WL_E = 2 * W13_E + 2 * W2_E + WIN_E + WOUT_E;
constexpr size_t WS_END = WS_W + 4 * WL_E * 2;
static_assert(WS_U + (size_t)MT * FF * 2 <= WS_PA && WS_PH + (size_t)MT * PHW * 4 <= WS_PA && WS_PA + (size_t)MT * PAW * 2 <= WS_VT && WS_VT + (size_t)NB * 8 * 64 * VTOK * 2 <= WS_SLOC && WS_SLOC + (size_t)NHU * 4096 * 4 <= WS_W, "ws map");
static_assert(WS_DEC + (size_t)NHU * 64 * 4 <= WS_X && WS_X + (size_t)MT * DM * 4 <= WS_XN && WS_XN + (size_t)MT * DM * 2 <= WS_O && WS_O + (size_t)MT * DM * 2 <= WS_U, "ws map 2");

constexpr int LDS_BYTES = 163840;
constexpr int NPHASE = 2 + 12 * DEPTH;

struct Args {
    const float *x, *c, *ctx, *c_ctx, *ada_w, *ada_b, *norm_g, *w1, *w3, *w2, *w_in, *w_out, *lb_logits, *hg_norm_g, *rpb, *sink, *final_g;
    float* out; unsigned char* ws; int ph_lo, ph_hi;
};

typedef const __attribute__((address_space(4))) Args* ArgsP;
__device__ __forceinline__ unsigned pk2(float lo, float hi) { return pg8::cvt_pk_bf16(lo, hi); }
__device__ __forceinline__ unsigned f2bf(float f) { return pg8::cvt_pk_bf16(f, 0.f) & 0xffffu; }
__device__ __forceinline__ float xmax16(float x) { const unsigned u = __builtin_bit_cast(unsigned, x); const auto r = __builtin_amdgcn_permlane16_swap(u, u, false, false); const unsigned r0 = r[0], r1 = r[1]; return fmaxf(__builtin_bit_cast(float, r0), __builtin_bit_cast(float, r1)); }
__device__ __forceinline__ float xmax32(float x) { const unsigned u = __builtin_bit_cast(unsigned, x); const auto r = __builtin_amdgcn_permlane32_swap(u, u, false, false); const unsigned r0 = r[0], r1 = r[1]; return fmaxf(__builtin_bit_cast(float, r0), __builtin_bit_cast(float, r1)); }
__device__ __forceinline__ float xsum16(float x) { const unsigned u = __builtin_bit_cast(unsigned, x); const auto r = __builtin_amdgcn_permlane16_swap(u, u, false, false); const unsigned r0 = r[0], r1 = r[1]; return __builtin_bit_cast(float, r0) + __builtin_bit_cast(float, r1); }
__device__ __forceinline__ float xsum32(float x) { const unsigned u = __builtin_bit_cast(unsigned, x); const auto r = __builtin_amdgcn_permlane32_swap(u, u, false, false); const unsigned r0 = r[0], r1 = r[1]; return __builtin_bit_cast(float, r0) + __builtin_bit_cast(float, r1); }
__device__ __forceinline__ float wave_sum(float v) {
#pragma unroll
    for (int o = 1; o < 16; o <<= 1) v += __shfl_xor(v, o);
    return xsum32(xsum16(v));
}
__device__ __forceinline__ float sigmoidf_(float z) { return __builtin_amdgcn_rcpf(1.0f + __builtin_amdgcn_exp2f(-1.4426950408889634f * z)); }
__device__ __forceinline__ float siluf_(float z) { return z * __builtin_amdgcn_rcpf(1.0f + __builtin_amdgcn_exp2f(-1.4426950408889634f * z)); }
__device__ __forceinline__ bf16* wptr(unsigned char* ws, int l) { return (bf16*)(ws + WS_W) + (size_t)l * WL_E; }
__device__ __forceinline__ bf16* w13p(unsigned char* ws, int l, int s) { return wptr(ws, l) + (size_t)s * W13_E; }
__device__ __forceinline__ bf16* w2p(unsigned char* ws, int l, int s) { return wptr(ws, l) + 2 * W13_E + (size_t)s * W2_E; }
__device__ __forceinline__ bf16* winp(unsigned char* ws, int l) { return wptr(ws, l) + 2 * W13_E + 2 * W2_E; }
__device__ __forceinline__ bf16* woutp(unsigned char* ws, int l) { return wptr(ws, l) + 2 * W13_E + 2 * W2_E + WIN_E; }

using pg8::Unit;
struct EpiSwiglu {
    static constexpr bool PERM = false, AFTER_DRAIN = false;
    bf16* U;
    __device__ __forceinline__ void operator()(const f32x4 (&acc)[2][2][4][2], const Unit& u, int wr, int wc, int fr, int fq) const {
        const int row0 = u.pm * 256 + wr * 64 + fr, col0 = u.pn * 128 + wc * 16 + 4 * fq;
#pragma unroll
        for (int ai = 0; ai < 2; ++ai)
#pragma unroll
            for (int m = 0; m < 4; ++m) { bf16* rp = U + (size_t)(row0 + ai * 128 + m * 16) * FF + col0;
#pragma unroll
                for (int bj = 0; bj < 2; ++bj) { const f32x4 a = acc[ai][bj][m][0], b = acc[ai][bj][m][1];
                    u32x2 w; w.x = pg8::cvt_pk_bf16(siluf_(a[0]) * b[0], siluf_(a[1]) * b[1]); w.y = pg8::cvt_pk_bf16(siluf_(a[2]) * b[2], siluf_(a[3]) * b[3]);
                    *(u32x2*)(rp + bj * 64) = w; } }
    }
};
struct EpiResid {
    static constexpr bool PERM = false, AFTER_DRAIN = false;
    float* X; const float* gate  ; float coef; int ntfull; float* PART; int ntsplit;
    __device__ __forceinline__ void operator()(const f32x4 (&acc)[2][2][4][2], const Unit& u, int wr, int wc, int fr, int fq) const {
        const int row0 = u.pm * 256 + wr * 64 + fr, col0 = u.pn * 256 + wc * 32 + 4 * fq;
        const int bi = u.pm < 64 ? (u.pm >> 4) : 4;
        const float* gp = gate + (size_t)bi * NMODV + col0;
        const bool full = u.nt == ntfull;
        float* base = full ? X + (size_t)row0 * DM + col0 : PART + ((size_t)(u.k0 / (ntsplit * 64)) * MC + (row0 - ML)) * DM + col0;
#pragma unroll
        for (int bj = 0; bj < 2; ++bj)
#pragma unroll
            for (int n = 0; n < 2; ++n) { const f32x4 gv = *(const f32x4*)(gp + bj * 128 + n * 16) * coef;
                float* cb = base + bj * 128 + n * 16;
                if (full) {
                    f32x4 xv[2][4];
#pragma unroll
                    for (int ai = 0; ai < 2; ++ai)
#pragma unroll
                        for (int m = 0; m < 4; ++m) xv[ai][m] = *(const f32x4*)(cb + (size_t)(ai * 128 + m * 16) * DM);
#pragma unroll
                    for (int ai = 0; ai < 2; ++ai)
#pragma unroll
                        for (int m = 0; m < 4; ++m) *(f32x4*)(cb + (size_t)(ai * 128 + m * 16) * DM) = xv[ai][m] + gv * acc[ai][bj][m][n];
                } else {
#pragma unroll
                    for (int ai = 0; ai < 2; ++ai)
#pragma unroll
                        for (int m = 0; m < 4; ++m) *(f32x4*)(cb + (size_t)(ai * 128 + m * 16) * DM) = gv * acc[ai][bj][m][n]; } }
    }
};
struct EpiIn {
    static constexpr bool PERM = false, AFTER_DRAIN = false;
    float* PH; bf16* PA; bf16* VT; const float* lb  ; const float* rope  ;
    __device__ __forceinline__ void operator()(const f32x4 (&acc)[2][2][4][2], const Unit& u, int wr, int wc, int fr, int fq) const {
        const int rloc0 = wr * 64 + fr;
        const bool isctx = u.pm >= 64;
        const int vb = isctx ? (u.pm - 64) : (u.pm >> 4);
        const int tok0 = isctx ? SEQ : (u.pm & 15) * 256;
#pragma unroll
        for (int bj = 0; bj < 2; ++bj) {
            const int cbase = u.pn * 256 + bj * 128 + wc * 32;
            if (cbase < 1280) {
                const int blk = cbase >> 8;
#pragma unroll
                for (int n = 0; n < 2; ++n) { const int col = cbase + 16 * n + 4 * fq;
                    f32x4 lbv = (f32x4){0.f, 0.f, 0.f, 0.f};
                    if (blk == 1 || blk == 2) lbv = *(const f32x4*)(lb + (blk - 1) * 256 + (col - 256 * blk));
#pragma unroll
                    for (int ai = 0; ai < 2; ++ai)
#pragma unroll
                        for (int m = 0; m < 4; ++m) { f32x4 v = acc[ai][bj][m][n], o;
                            if (blk == 0 || blk == 4) { o[0] = siluf_(v[0]); o[1] = siluf_(v[1]); o[2] = siluf_(v[2]); o[3] = siluf_(v[3]); }
                            else if (blk == 3) o = v;
                            else {
#pragma unroll
                                for (int j = 0; j < 4; ++j) o[j] = __logf(lbv[j] + (1.0f - lbv[j]) * sigmoidf_(v[j])); }
                            *(f32x4*)(PH + (size_t)(u.pm * 256 + rloc0 + ai * 128 + m * 16) * PHW + col) = o; } }
            } else {
                int kind, pcol = 0, vh = 0;
                float sc = 1.0f;
                if (cbase < 1664)      { kind = 0; pcol = cbase - 1280; sc = 0.125f * 1.4426950408889634f; }
                else if (cbase < 2048) { kind = 0; pcol = 384 + cbase - 1664; }
                else if (cbase < 2432) { kind = 2; vh = (cbase - 2048) >> 6; }
                else if (cbase < 2816) { kind = isctx ? 0 : 1; pcol = 768 + cbase - 2432; sc = 0.125f * 1.4426950408889634f; }
                else if (cbase < 2944) { kind = isctx ? 0 : 1; pcol = 1152 + cbase - 2816; }
                else                   { kind = 2; vh = 6 + ((cbase - 2944) >> 6); }
                if (kind == 2) {
                    const int d0 = (cbase & 63) + 4 * fq;
                    bf16* vp = VT + ((size_t)((vb * 8 + vh) * 64 + d0)) * VTOK + tok0 + rloc0;
#pragma unroll
                    for (int ai = 0; ai < 2; ++ai)
#pragma unroll
                        for (int m = 0; m < 4; ++m)
#pragma unroll
                            for (int n = 0; n < 2; ++n) { const f32x4 v = acc[ai][bj][m][n];
#pragma unroll
                                for (int j = 0; j < 4; ++j) vp[(size_t)(16 * n + j) * VTOK + ai * 128 + m * 16] = (bf16)f2bf(v[j]); }
                } else if (kind == 0) {
#pragma unroll
                    for (int ai = 0; ai < 2; ++ai)
#pragma unroll
                        for (int m = 0; m < 4; ++m) { bf16* rp = PA + (size_t)(u.pm * 256 + rloc0 + ai * 128 + m * 16) * PAW + pcol + 4 * fq;
#pragma unroll
                            for (int n = 0; n < 2; ++n) { const f32x4 v = acc[ai][bj][m][n] * sc; u32x2 w; w.x = pg8::cvt_pk_bf16(v[0], v[1]); w.y = pg8::cvt_pk_bf16(v[2], v[3]); *(u32x2*)(rp + 16 * n) = w; } }
                } else {
                    const bool colaxis = (cbase & 32) != 0;
#pragma unroll
                    for (int ai = 0; ai < 2; ++ai)
#pragma unroll
                        for (int m = 0; m < 4; ++m) { const int r = u.pm * 256 + rloc0 + ai * 128 + m * 16, t = r & (SEQ - 1), pos = colaxis ? (t & 63) : (t >> 6);
                            const f32x4 cs = *(const f32x4*)(rope + pos * 16 + 4 * fq), sn = *(const f32x4*)(rope + 1024 + pos * 16 + 4 * fq);
                            const f32x4 x1 = acc[ai][bj][m][0], x2 = acc[ai][bj][m][1];
                            const f32x4 o1 = (x1 * cs - x2 * sn) * sc, o2 = (x1 * sn + x2 * cs) * sc;
                            bf16* rp = PA + (size_t)r * PAW + pcol + 4 * fq;
                            u32x2 w; w.x = pg8::cvt_pk_bf16(o1[0], o1[1]); w.y = pg8::cvt_pk_bf16(o1[2], o1[3]); *(u32x2*)rp = w;
                            w.x = pg8::cvt_pk_bf16(o2[0], o2[1]); w.y = pg8::cvt_pk_bf16(o2[2], o2[3]); *(u32x2*)(rp + 16) = w; }
                }
            }
        }
    }
};

struct EpiAll {
    static constexpr bool PERM = false, AFTER_DRAIN = false;
    unsigned char* ws; int mode  ; int l, gi; float coef; int ntfull, ntsplit;
    __device__ __forceinline__ void operator()(const f32x4 (&acc)[2][2][4][2], const Unit& u, int wr, int wc, int fr, int fq) const {
        if (mode == 0) { EpiSwiglu E{(bf16*)(ws + WS_U)}; E(acc, u, wr, wc, fr, fq); }
        else if (mode == 1) { EpiResid E{(float*)(ws + WS_X), (const float*)(ws + WS_MODV) + (size_t)l * 5 * NMODV + gi * DM, coef, ntfull, (float*)(ws + WS_SLOC), ntsplit}; E(acc, u, wr, wc, fr, fq); }
        else { EpiIn E{(float*)(ws + WS_PH), (bf16*)(ws + WS_PA), (bf16*)(ws + WS_VT), (const float*)(ws + WS_LB) + l * 512, (const float*)(ws + WS_ROPE)}; E(acc, u, wr, wc, fr, fq); }
    }
};

__device__ __forceinline__ void p0_transpose_item(const float* W, int K, int N, bf16* WT, int mode, LAS float* scr, int item, int lane) {
    const int nblk = N / 32, kb = item / nblk, nb = item % nblk, k0 = 64 * kb, n0 = 32 * nb;
    float tv[32];
#pragma unroll
    for (int i = 0; i < 32; ++i) { const int kk = 2 * i + (lane >> 5); tv[i] = W[(size_t)(k0 + kk) * N + n0 + (lane & 31)]; }
#pragma unroll
    for (int i = 0; i < 32; ++i) { const int kk = 2 * i + (lane >> 5); scr[kk * 33 + (lane & 31)] = tv[i]; }
    asm volatile("s_waitcnt lgkmcnt(0)" ::: "memory");
    const int c = lane & 7;
#pragma unroll
    for (int j = 0; j < 4; ++j) { const int n = (lane >> 3) + 8 * j; const LAS float* s = scr + (8 * c) * 33 + n;
        u32x4 o; o.x = pk2(s[0 * 33], s[1 * 33]); o.y = pk2(s[2 * 33], s[3 * 33]); o.z = pk2(s[4 * 33], s[5 * 33]); o.w = pk2(s[6 * 33], s[7 * 33]);
        const int ns = n0 + n; const int nd = mode == 0 ? ns : (32 * (ns >> 4) + (ns & 15) + (mode == 2 ? 16 : 0));
        *(u32x4*)(WT + (size_t)nd * K + k0 + 8 * c) = o; }
    asm volatile("s_waitcnt lgkmcnt(0)" ::: "memory");
}

__device__ __forceinline__ void phase_prologue(ArgsP a, LAS unsigned char* L, int tid, int lane, int wave) {
    asm volatile("" : "+s"(a) :: "memory");
    unsigned char* ws = a->ws;
    float* MODV = (float*)(ws + WS_MODV);
    LAS float* sv = (LAS float*)L;
    LAS float* part = (LAS float*)(L + 20480);
    for (int i = tid; i < 5 * DM; i += 512) { const int bi = i >> 10, k = i & 1023; const float v = bi < 4 ? a->c[bi * DM + k] : a->c_ctx[k]; sv[i] = siluf_(v); }
    __syncthreads();
    for (int item = blockIdx.x; item < DEPTH * (NMODV / 64); item += gridDim.x) {
        const int l = item / (NMODV / 64), cgp = item % (NMODV / 64);
        const float* wp = a->ada_w + (size_t)l * DM * NMODV + (size_t)(128 * wave) * NMODV + cgp * 64 + lane;
        float ac[5] = {0.f, 0.f, 0.f, 0.f, 0.f};
        for (int k0 = 0; k0 < 128; k0 += 32) { float w[32];
#pragma unroll
            for (int j = 0; j < 32; ++j) w[j] = wp[(size_t)(k0 + j) * NMODV];
#pragma unroll
            for (int j = 0; j < 32; ++j)
#pragma unroll
                for (int bi = 0; bi < 5; ++bi) ac[bi] += sv[bi * DM + 128 * wave + k0 + j] * w[j]; }
#pragma unroll
        for (int bi = 0; bi < 5; ++bi) part[(wave * 5 + bi) * 64 + lane] = ac[bi];
        __syncthreads();
        if (tid < 320) { const int bi = tid >> 6, ln = tid & 63; float s = a->ada_b[l * NMODV + cgp * 64 + ln];
#pragma unroll
            for (int w = 0; w < 8; ++w) s += part[(w * 5 + bi) * 64 + ln];
            MODV[(size_t)(l * 5 + bi) * NMODV + cgp * 64 + ln] = s; }
        __syncthreads();
    }
    {
        LAS float* scr = (LAS float*)(L + 32768 + wave * 8448);
        const int gw = blockIdx.x * 8 + wave, NGW = gridDim.x * 8;
        constexpr int I1 = (DM / 64) * (FF / 32), I2 = (FF / 64) * (DM / 32), IIN = (DM / 64) * (INW / 32), IOUT = (DM / 64) * (DM / 32);
        constexpr int PERL = 4 * I1 + 2 * I2 + IIN + IOUT;
        for (int it = gw; it < DEPTH * PERL; it += NGW) {
            const int l = it / PERL; int r = it % PERL;
            if (r < 4 * I1) { const int q = r / I1, s = q >> 1, which = q & 1; r -= q * I1;
                const float* src = (which ? a->w3 : a->w1) + (size_t)(l * 2 + s) * DM * FF;
                p0_transpose_item(src, DM, FF, w13p(ws, l, s), 1 + which, scr, r, lane); continue; }
            r -= 4 * I1;
            if (r < 2 * I2) { const int s = r / I2; r -= s * I2; p0_transpose_item(a->w2 + (size_t)(l * 2 + s) * FF * DM, FF, DM, w2p(ws, l, s), 0, scr, r, lane); continue; }
            r -= 2 * I2;
            if (r < IIN) { p0_transpose_item(a->w_in + (size_t)l * DM * INW, DM, INW, winp(ws, l), 0, scr, r, lane); continue; }
            r -= IIN;
            p0_transpose_item(a->w_out + (size_t)l * DM * DM, DM, DM, woutp(ws, l), 0, scr, r, lane);
        }
    }
    {
        f32x4* X4 = (f32x4*)(ws + WS_X); const f32x4* x4 = (const f32x4*)a->x; const f32x4* c4 = (const f32x4*)a->ctx;
        const size_t n1 = (size_t)ML * DM / 4, n2 = (size_t)MC * DM / 4, gs = (size_t)gridDim.x * 512;
        for (size_t i = (size_t)blockIdx.x * 512 + tid; i < n1; i += gs) X4[i] = x4[i];
        for (size_t i = (size_t)blockIdx.x * 512 + tid; i < n2; i += gs) X4[n1 + i] = c4[i];
    }
    if (blockIdx.x == 0) {
        float* rope = (float*)(ws + WS_ROPE);
        for (int i = tid; i < 1024; i += 512) { const int pos = i >> 4, f = i & 15; const float inv = powf(10000.0f, -(float)f / 16.0f), ang = (float)pos * inv; rope[i] = cosf(ang); rope[1024 + i] = sinf(ang); }
        float* LB = (float*)(ws + WS_LB);
        { const int i = tid;
            float lg[DEPTH], mx = -1e30f;
#pragma unroll
            for (int l = 0; l < DEPTH; ++l) { lg[l] = a->lb_logits[l * 512 + i]; mx = fmaxf(mx, lg[l]); }
            float sum = 0.f;
#pragma unroll
            for (int l = 0; l < DEPTH; ++l) { lg[l] = expf(lg[l] - mx); sum += lg[l]; }
            float cum = 0.f; const float s0 = lg[0] / sum;
#pragma unroll
            for (int l = 0; l < DEPTH; ++l) { cum += lg[l] / sum; LB[l * 512 + i] = cum - s0; } }
    }
}

__device__ __forceinline__ void phase_norm(ArgsP a, int l, int sub, int nrows, int nsplit, int lane, int wave) {
    asm volatile("" : "+s"(a) :: "memory");
    unsigned char* ws = a->ws;
    const float* X = (const float*)(ws + WS_X); float* Xw = (float*)(ws + WS_X); const float* PART = (const float*)(ws + WS_SLOC); bf16* XN = (bf16*)(ws + WS_XN);
    const float* g = a->norm_g + (size_t)(l * 3 + sub) * DM;
    const float* mv = (const float*)(ws + WS_MODV) + (size_t)l * 5 * NMODV;
    if (nsplit > 0) {
        const float* sh = mv + (size_t)4 * NMODV + (3 * sub) * DM, *sc = sh + DM;
        for (int r = blockIdx.x * 8 + wave; r < MC; r += gridDim.x * 8) {
            const int row = ML + r;
            f32x4 v[4], pv[6][4];
#pragma unroll
            for (int j = 0; j < 4; ++j) v[j] = ((const f32x4*)(X + (size_t)row * DM))[lane + 64 * j];
#pragma unroll
            for (int sp = 0; sp < 6; ++sp) if (sp < nsplit) {
#pragma unroll
                for (int j = 0; j < 4; ++j) pv[sp][j] = ((const f32x4*)(PART + ((size_t)sp * MC + r) * DM))[lane + 64 * j]; }
#pragma unroll
            for (int sp = 0; sp < 6; ++sp) if (sp < nsplit) {
#pragma unroll
                for (int j = 0; j < 4; ++j) v[j] = v[j] + pv[sp][j]; }
            float ss = 0.f;
#pragma unroll
            for (int j = 0; j < 4; ++j) { ((f32x4*)(Xw + (size_t)row * DM))[lane + 64 * j] = v[j]; ss += (v[j][0] * v[j][0] + v[j][1] * v[j][1]) + (v[j][2] * v[j][2] + v[j][3] * v[j][3]); }
            const float rstd = rsqrtf(wave_sum(ss) * (1.0f / DM) + EPS);
            u32x2* o = (u32x2*)(XN + (size_t)row * DM) + lane;
#pragma unroll
            for (int j = 0; j < 4; ++j) { const f32x4 gg = ((const f32x4*)g)[lane + 64 * j], s4 = ((const f32x4*)sc)[lane + 64 * j], h4 = ((const f32x4*)sh)[lane + 64 * j];
                const f32x4 y = v[j] * rstd * gg * (s4 + 1.0f) + h4;
                u32x2 w; w.x = pg8::cvt_pk_bf16(y[0], y[1]); w.y = pg8::cvt_pk_bf16(y[2], y[3]); o[64 * j] = w; }
        }
        nrows = ML;
    }
    for (int gw = blockIdx.x * 8 + wave; gw * 9 < nrows; gw += gridDim.x * 8) {
    const int rbeg = gw * 9, rend = min(nrows, rbeg + 9);
    int cur_bi = -1; f32x4 GS[4], HH[4];
    for (int base = rbeg; base < rend; base += 3) {
        f32x4 v[3][4]; float s[3];
#pragma unroll
        for (int q = 0; q < 3; ++q) { const int row = min(base + q, rend - 1); const f32x4* xr = (const f32x4*)(X + (size_t)row * DM) + lane;
#pragma unroll
            for (int j = 0; j < 4; ++j) v[q][j] = xr[64 * j];
 }
#pragma unroll
        for (int q = 0; q < 3; ++q) { s[q] = 0.f;
#pragma unroll
            for (int j = 0; j < 4; ++j) s[q] += (v[q][j][0] * v[q][j][0] + v[q][j][1] * v[q][j][1]) + (v[q][j][2] * v[q][j][2] + v[q][j][3] * v[q][j][3]); }
#pragma unroll
        for (int o = 1; o < 64; o <<= 1) { s[0] += __shfl_xor(s[0], o); s[1] += __shfl_xor(s[1], o); s[2] += __shfl_xor(s[2], o); }
#pragma unroll
        for (int q = 0; q < 3; ++q) { const int row = base + q; if (row < rend) {
            const int bi = row < ML ? row / SEQ : 4;
            if (bi != cur_bi) {
                const float* sh = mv + (size_t)bi * NMODV + (3 * sub) * DM, *sc = sh + DM;
#pragma unroll
                for (int j = 0; j < 4; ++j) { GS[j] = ((const f32x4*)g)[lane + 64 * j] * (((const f32x4*)sc)[lane + 64 * j] + 1.0f); HH[j] = ((const f32x4*)sh)[lane + 64 * j]; }
                cur_bi = bi; }
            const float rstd = rsqrtf(s[q] * (1.0f / DM) + EPS);
            u32x2* o = (u32x2*)(XN + (size_t)row * DM) + lane;
#pragma unroll
            for (int j = 0; j < 4; ++j) { const f32x4 y = v[q][j] * rstd * GS[j] + HH[j];
                u32x2 w; w.x = pg8::cvt_pk_bf16(y[0], y[1]); w.y = pg8::cvt_pk_bf16(y[2], y[3]); o[64 * j] = w; } } }
    }
    }
}
__device__ __forceinline__ void phase_final(ArgsP a, int lane, int wave) {
    asm volatile("" : "+s"(a) :: "memory");
    const float* X = (const float*)(a->ws + WS_X);
    const int gw = blockIdx.x * 8 + wave, NGW = gridDim.x * 8;
    for (int base = gw * 4; base < ML; base += NGW * 4) {
        f32x4 v[4][4]; float s[4];
#pragma unroll
        for (int q = 0; q < 4; ++q) { const f32x4* xr = (const f32x4*)(X + (size_t)(base + q) * DM) + lane;
#pragma unroll
            for (int j = 0; j < 4; ++j) v[q][j] = xr[64 * j]; }
#pragma unroll
        for (int q = 0; q < 4; ++q) { s[q] = 0.f;
#pragma unroll
            for (int j = 0; j < 4; ++j) s[q] += (v[q][j][0] * v[q][j][0] + v[q][j][1] * v[q][j][1]) + (v[q][j][2] * v[q][j][2] + v[q][j][3] * v[q][j][3]); }
#pragma unroll
        for (int o = 1; o < 64; o <<= 1) { s[0] += __shfl_xor(s[0], o); s[1] += __shfl_xor(s[1], o); s[2] += __shfl_xor(s[2], o); s[3] += __shfl_xor(s[3], o); }
#pragma unroll
        for (int q = 0; q < 4; ++q) { const float rstd = rsqrtf(s[q] * (1.0f / DM) + EPS);
            f32x4* o = (f32x4*)(a->out + (size_t)(base + q) * DM) + lane;
#pragma unroll
            for (int j = 0; j < 4; ++j) o[64 * j] = v[q][j] * rstd * ((const f32x4*)a->final_g)[lane + 64 * j]; }
    }
}

constexpr int HS = 72;
__device__ __forceinline__ int hg_row(int b, bool isctx, int lc, int dir, int s) {
    const int p = 64 * lc + s, Lm1 = isctx ? (CTXL - 1) : (SEQ - 1), tok = dir ? (Lm1 - p) : p;
    return isctx ? (ML + b * CTXL + tok) : (b * SEQ + tok);
}
__device__ __forceinline__ bf16x8 lds_frag(const LAS bf16* p) { return *(const LAS bf16x8*)p; }
__device__ __forceinline__ void phase_h1(ArgsP a, LAS unsigned char* L, int tid, int lane, int wave) {
    asm volatile("" : "+s"(a) :: "memory");
    unsigned char* ws = a->ws;
    const float* PH = (const float*)(ws + WS_PH); float* SLOC = (float*)(ws + WS_SLOC); float* DEC = (float*)(ws + WS_DEC);
    const int grp = wave >> 2, w4 = wave & 3;
    LAS unsigned char* GB = L + grp * 19456;
    LAS float* segtot = (LAS float*)GB;
    LAS bf16* KdT = (LAS bf16*)(GB + 1024);
    LAS bf16* VTl = KdT + 64 * HS;
    const int fr = lane & 15, g = lane >> 4;
    for (int pr = blockIdx.x; pr < NHU / 2; pr += gridDim.x) {
        const int unit = 2 * pr + grp;
        const int c = unit % NCH, dir = (unit / NCH) & 1, h = (unit / (2 * NCH)) & 3, b = unit / (8 * NCH);
        const bool isctx = c < 4; const int lc = isctx ? c : c - 4;
        float lf[16], cu[16], vv[16]; float run = 0.f;
#pragma unroll
        for (int i = 0; i < 16; ++i) { const size_t r = (size_t)hg_row(b, isctx, lc, dir, 16 * w4 + i) * PHW; lf[i] = PH[r + 256 * (1 + dir) + 64 * h + lane]; vv[i] = PH[r + 768 + 64 * h + lane]; }
#pragma unroll
        for (int i = 0; i < 16; ++i) { run += lf[i]; cu[i] = run; }
        segtot[w4 * 64 + lane] = run;
        __syncthreads();
        float P = 0.f, off = 0.f;
#pragma unroll
        for (int sg = 0; sg < 4; ++sg) { if (sg == w4) off = P; P += segtot[sg * 64 + lane]; }
        float kd[16];
#pragma unroll
        for (int i = 0; i < 16; ++i) kd[i] = (1.0f - __expf(lf[i])) * __expf(P - (cu[i] + off));
#pragma unroll
        for (int hh = 0; hh < 2; ++hh) {
            { u32x4 w; w.x = pk2(kd[8 * hh + 0], kd[8 * hh + 1]); w.y = pk2(kd[8 * hh + 2], kd[8 * hh + 3]); w.z = pk2(kd[8 * hh + 4], kd[8 * hh + 5]); w.w = pk2(kd[8 * hh + 6], kd[8 * hh + 7]); *(LAS u32x4*)(KdT + lane * HS + 16 * w4 + 8 * hh) = w; }
            { u32x4 w; w.x = pk2(vv[8 * hh + 0], vv[8 * hh + 1]); w.y = pk2(vv[8 * hh + 2], vv[8 * hh + 3]); w.z = pk2(vv[8 * hh + 4], vv[8 * hh + 5]); w.w = pk2(vv[8 * hh + 6], vv[8 * hh + 7]); *(LAS u32x4*)(VTl + lane * HS + 16 * w4 + 8 * hh) = w; } }
        if (w4 == 0) DEC[(size_t)unit * 64 + lane] = __expf(P);
        __syncthreads();
        const int kt = w4;
#pragma unroll
        for (int dt = 0; dt < 4; ++dt) { f32x4 acc = (f32x4){0.f, 0.f, 0.f, 0.f};
#pragma unroll
            for (int ks = 0; ks < 2; ++ks) acc = __builtin_amdgcn_mfma_f32_16x16x32_bf16(lds_frag(KdT + (16 * kt + fr) * HS + 32 * ks + 8 * g), lds_frag(VTl + (16 * dt + fr) * HS + 32 * ks + 8 * g), acc, 0, 0, 0);
            float* sp = SLOC + (size_t)unit * 4096 + (size_t)(16 * kt + 4 * g) * 64 + 16 * dt + fr;
#pragma unroll
            for (int j = 0; j < 4; ++j) sp[j * 64] = acc[j]; }
        __syncthreads();
    }
}
__device__ __forceinline__ void phase_h2(ArgsP a, int tid) {
    asm volatile("" : "+s"(a) :: "memory");
    float* SLOC = (float*)(a->ws + WS_SLOC); const float* DEC = (const float*)(a->ws + WS_DEC);
    for (int e = blockIdx.x * 512 + tid; e < NB * 4 * 2 * 4096; e += gridDim.x * 512) {
        const int chain = e >> 12, el = e & 4095; float* sp = SLOC + (size_t)chain * NCH * 4096 + el; const float* dp = DEC + (size_t)chain * NCH * 64 + (el >> 6);
        float S = 0.f;
        for (int c0 = 0; c0 < NCH; c0 += 4) { float sl[4], d[4];
#pragma unroll
            for (int i = 0; i < 4; ++i) { sl[i] = sp[(size_t)(c0 + i) * 4096]; d[i] = dp[(c0 + i) * 64]; }
#pragma unroll
            for (int i = 0; i < 4; ++i) { sp[(size_t)(c0 + i) * 4096] = S; S = d[i] * S + sl[i]; } }
    }
}
__device__ __forceinline__ void phase_h3(ArgsP a, LAS unsigned char* L, int l, bool need_ctx, int tid, int lane, int wave) {
    asm volatile("" : "+s"(a) :: "memory");
    unsigned char* ws = a->ws;
    const float* PH = (const float*)(ws + WS_PH); const float* SLOC = (const float*)(ws + WS_SLOC); bf16* O = (bf16*)(ws + WS_O);
    constexpr int DREG = 70656;
    const int dir = wave >> 2, w4 = wave & 3;
    LAS unsigned char* DB = L + dir * DREG;
    LAS float* segtot = (LAS float*)DB;
    LAS bf16* Qd = (LAS bf16*)(DB + 1024);
    LAS bf16* Qi = Qd + 64 * HS;
    LAS bf16* VTl = Qi + 64 * HS;
    LAS bf16* SpT = VTl + 64 * HS;
    LAS bf16* Ab = SpT + 64 * HS;
    LAS bf16* KS = Ab + 64 * HS;
    LAS float* Od = (LAS float*)(DB + 1024);
    const LAS float* Od0 = (const LAS float*)(L + 1024); const LAS float* Od1 = (const LAS float*)(L + DREG + 1024);
    const int fr = lane & 15, g = lane >> 4;
    const int tc0 = need_ctx ? 0 : 4, ntc = NCH - tc0, nunits = NB * 4 * ntc;
    for (int unit = blockIdx.x; unit < nunits; unit += gridDim.x) {
        const int tc = tc0 + unit % ntc, h = (unit / ntc) & 3, b = unit / (4 * ntc);
        const bool isctx = tc < 4; const int tcl = isctx ? tc : tc - 4, nch = isctx ? 4 : 64;
        const int lc = dir ? (nch - 1 - tcl) : tcl, c = isctx ? lc : 4 + lc;
        const size_t hu = (size_t)(((b * 4 + h) * 2 + dir) * NCH + c);
        float lf[16], cu[16], vv[16], qq[16], sp[16]; float run = 0.f;
#pragma unroll
        for (int i = 0; i < 16; ++i) { const size_t r = (size_t)hg_row(b, isctx, lc, dir, 16 * w4 + i) * PHW; lf[i] = PH[r + 256 * (1 + dir) + 64 * h + lane]; vv[i] = PH[r + 768 + 64 * h + lane]; qq[i] = PH[r + 64 * h + lane];
            sp[i] = SLOC[hu * 4096 + (size_t)(16 * w4 + i) * 64 + lane]; }
#pragma unroll
        for (int i = 0; i < 16; ++i) { run += lf[i]; cu[i] = run; }
        segtot[w4 * 64 + lane] = run;
        __syncthreads();
        float P = 0.f, Rr[4];
#pragma unroll
        for (int sg = 0; sg < 4; ++sg) { Rr[sg] = P; P += segtot[sg * 64 + lane]; }
        const int jb = w4;
        float Rj = Rr[0];
#pragma unroll
        for (int ii = 1; ii < 4; ++ii) if (ii == jb) Rj = Rr[ii];
#pragma unroll
        for (int i = 0; i < 16; ++i) { const int s = 16 * w4 + i; const float cs = cu[i] + Rj, kv = 1.0f - __expf(lf[i]);
            Qd[s * HS + lane] = (bf16)f2bf(qq[i] * __expf(cs));
            Qi[s * HS + lane] = (bf16)f2bf(qq[i] * __expf(cs - Rj));
#pragma unroll
            for (int ii = 0; ii < 4; ++ii) if (ii >= jb) { const int ro = (ii == 0 ? 0 : ii == 1 ? 16 : ii == 2 ? 48 : 96); KS[(ro + s) * HS + lane] = (bf16)f2bf(kv * __expf(Rr[ii] - cs)); } }
#pragma unroll
        for (int hh = 0; hh < 2; ++hh) {
            { u32x4 w; w.x = pk2(vv[8 * hh + 0], vv[8 * hh + 1]); w.y = pk2(vv[8 * hh + 2], vv[8 * hh + 3]); w.z = pk2(vv[8 * hh + 4], vv[8 * hh + 5]); w.w = pk2(vv[8 * hh + 6], vv[8 * hh + 7]); *(LAS u32x4*)(VTl + lane * HS + 16 * w4 + 8 * hh) = w; }
            { u32x4 w; w.x = pk2(sp[8 * hh + 0], sp[8 * hh + 1]); w.y = pk2(sp[8 * hh + 2], sp[8 * hh + 3]); w.z = pk2(sp[8 * hh + 4], sp[8 * hh + 5]); w.w = pk2(sp[8 * hh + 6], sp[8 * hh + 7]); *(LAS u32x4*)(SpT + lane * HS + 16 * w4 + 8 * hh) = w; } }
        __syncthreads();
        const int ib = w4;
        f32x4 acc[4];
#pragma unroll
        for (int dt = 0; dt < 4; ++dt) { acc[dt] = (f32x4){0.f, 0.f, 0.f, 0.f};
#pragma unroll
            for (int ks = 0; ks < 2; ++ks) acc[dt] = __builtin_amdgcn_mfma_f32_16x16x32_bf16(lds_frag(Qd + (16 * ib + fr) * HS + 32 * ks + 8 * g), lds_frag(SpT + (16 * dt + fr) * HS + 32 * ks + 8 * g), acc[dt], 0, 0, 0); }
        const int kro = (ib == 0 ? 0 : ib == 1 ? 16 : ib == 2 ? 48 : 96);
#pragma unroll
        for (int sb = 0; sb < 4; ++sb) {
            f32x4 cc = (f32x4){0.f, 0.f, 0.f, 0.f};
            if (sb <= ib) {
#pragma unroll
                for (int ks = 0; ks < 2; ++ks) cc = __builtin_amdgcn_mfma_f32_16x16x32_bf16(lds_frag(Qi + (16 * ib + fr) * HS + 32 * ks + 8 * g), lds_frag(KS + (kro + 16 * sb + fr) * HS + 32 * ks + 8 * g), cc, 0, 0, 0);
                if (sb == ib) {
#pragma unroll
                    for (int j = 0; j < 4; ++j) if (fr > 4 * g + j) cc[j] = 0.f; }
            }
#pragma unroll
            for (int j = 0; j < 4; ++j) Ab[(16 * ib + 4 * g + j) * HS + 16 * sb + fr] = (bf16)f2bf(cc[j]); }
        __syncthreads();
#pragma unroll
        for (int ks = 0; ks < 2; ++ks) if (ks <= (ib >> 1)) { const bf16x8 af = lds_frag(Ab + (16 * ib + fr) * HS + 32 * ks + 8 * g);
#pragma unroll
            for (int dt = 0; dt < 4; ++dt) acc[dt] = __builtin_amdgcn_mfma_f32_16x16x32_bf16(af, lds_frag(VTl + (16 * dt + fr) * HS + 32 * ks + 8 * g), acc[dt], 0, 0, 0); }
#pragma unroll
        for (int dt = 0; dt < 4; ++dt)
#pragma unroll
            for (int j = 0; j < 4; ++j) { const int t = 16 * ib + 4 * g + j, tl = dir ? 63 - t : t; Od[tl * 68 + 16 * dt + fr] = acc[dt][j]; }
        __syncthreads();
        {
            const int tokl = tid >> 3, d0 = 8 * (tid & 7);
            const int row = isctx ? (ML + b * CTXL + 64 * tcl + tokl) : (b * SEQ + 64 * tcl + tokl);
            float o[8]; float ss = 0.f;
#pragma unroll
            for (int i = 0; i < 8; ++i) { o[i] = Od0[tokl * 68 + d0 + i] + Od1[tokl * 68 + d0 + i]; ss += o[i] * o[i]; }
            ss += __shfl_xor(ss, 1); ss += __shfl_xor(ss, 2); ss += __shfl_xor(ss, 4);
            const float rstd = rsqrtf(ss * (1.0f / 64.0f) + EPS);
            const float* gp = PH + (size_t)row * PHW + 1024 + 64 * h + d0; const float* ng = a->hg_norm_g + l * 256 + 64 * h + d0;
            float y[8];
#pragma unroll
            for (int i = 0; i < 8; ++i) y[i] = o[i] * rstd * ng[i] * gp[i];
            u32x4 w; w.x = pg8::cvt_pk_bf16(y[0], y[1]); w.y = pg8::cvt_pk_bf16(y[2], y[3]); w.z = pg8::cvt_pk_bf16(y[4], y[5]); w.w = pg8::cvt_pk_bf16(y[6], y[7]);
            *(u32x4*)(O + (size_t)row * DM + 64 * h + d0) = w;
        }
        __syncthreads();
    }
}

constexpr int AS = 72;
constexpr int VS = 136;
constexpr float LOG2E = 1.4426950408889634f;
constexpr int CTR_WORD0 = 3584;
__device__ __forceinline__ void phase_attn(ArgsP a, LAS unsigned char* L, int l, bool need_ctx, int tid, int lane, int wave) {
    asm volatile("" : "+s"(a) :: "memory");
    unsigned char* ws = a->ws;
    const bf16* PA = (const bf16*)(ws + WS_PA); const bf16* VT = (const bf16*)(ws + WS_VT); bf16* O = (bf16*)(ws + WS_O);
    LAS bf16* Ks0 = (LAS bf16*)L;
    LAS bf16* Vs0 = Ks0 + 2 * 128 * AS;
    LAS float* rpbl = (LAS float*)(L + 2 * 128 * AS * 2 + 2 * 64 * VS * 2);
    volatile LAS unsigned* slot = (volatile LAS unsigned*)(L + LDS_BYTES - 32);
    unsigned* ctr = (unsigned*)(ws + WS_BAR) + CTR_WORD0 + l;
    const int fr = lane & 15, g = lane >> 4;
    const int srow = tid >> 3, sc8 = 8 * (tid & 7);
    const int kap = ((fr >> 2) << 3) + (fr & 3);
    const int nunits = need_ctx ? 816 : 768;
    for (;;) {
        __syncthreads();
        if (tid == 0) slot[0] = __hip_atomic_fetch_add(ctr, 1u, __ATOMIC_RELAXED, __HIP_MEMORY_SCOPE_AGENT);
        __syncthreads();
        const int unit = (int)slot[0];
        if (unit >= nunits) break;
        int kind, b, h, blk;
        if (unit < 384) { kind = 0; b = unit / 96; h = (unit % 96) >> 4; blk = unit & 15; }
        else if (unit < 768) { const int u = unit - 384; kind = 1; b = u / 96; h = (u % 96) >> 4; blk = u & 15; }
        else if (unit < 792) { const int u = unit - 768; kind = 2; b = u / 6; h = u % 6; blk = 0; }
        else { const int u = unit - 792; kind = 3; b = u / 6; h = u % 6; blk = 0; }
        const bool sw = (kind & 1) != 0, qctx = kind >= 2;
        const int quarter = wave & 3, cs = quarter == 0 ? 0 : quarter == 1 ? 8 : quarter == 2 ? 24 : 32;
        const int qc = 16 * quarter + fr, c0 = min(max(qc - 8, 0), 48);
        int qt[2], rr[2], rs[2], qlo[2];
#pragma unroll
        for (int t = 0; t < 2; ++t) {
            rr[t] = 4 * blk + 2 * (wave >> 2) + t;
            qt[t] = kind == 0 ? rr[t] * 4 + quarter : (kind == 1 ? blk * 16 : 0) + 2 * wave + t;
            rs[t] = min(max(rr[t] - 4, 0), 56); qlo[t] = 16 * qt[t]; }
        const int qbase = qctx ? ML + b * CTXL : b * SEQ;
        const int qcol = sw ? 768 + 64 * h : 64 * h;
        const int kcol = sw ? 1152 + 64 * (h / 3) : 384 + 64 * h;
        const int vh = sw ? 6 + h / 3 : h;
        const int ocol = sw ? 640 + 64 * h : 256 + 64 * h;
        const bf16* vtb = VT + (size_t)((b * 8 + vh) * 64) * VTOK;
        int nlatc = 0, lat0 = 0;
        if (kind == 0) { const int r0 = 4 * blk, rs0 = min(max(r0 - 4, 0), 56), rs3 = min(max(r0 - 1, 0), 56); lat0 = rs0; nlatc = (rs3 - rs0 + 8 + 1) >> 1; }
        else if (kind == 1) { const int ks = max(0, 256 * blk - 128), ke = min(SEQ, 256 * blk + 384); lat0 = ks; nlatc = (ke - ks) >> 7; }
        const int nch = 2 + nlatc;
        if (kind == 0) { const float* rp = a->rpb + (size_t)(l * 6 + h) * 465; for (int i = tid; i < 465; i += 512) rpbl[i] = rp[i] * LOG2E; }
        bf16x8 qf[2][2];
#pragma unroll
        for (int t = 0; t < 2; ++t)
#pragma unroll
            for (int ks = 0; ks < 2; ++ks) qf[t][ks] = *(const bf16x8*)(PA + (size_t)(qbase + qlo[t] + fr) * PAW + qcol + 32 * ks + 8 * g);
        float m_run[2], l_run[2]; f32x4 acc[2][4];
#pragma unroll
        for (int t = 0; t < 2; ++t) { m_run[t] = sw ? a->sink[l * 6 + h] * LOG2E : -1e30f; l_run[t] = (sw && g == 0) ? 1.0f : 0.f;
#pragma unroll
            for (int dt = 0; dt < 4; ++dt) acc[t][dt] = (f32x4){0.f, 0.f, 0.f, 0.f}; }
#define CHUNK_LOAD(c_, K0, K1, V0, V1) do { const int cc_ = (c_); int krow, vtok; \
            if (cc_ < 2) { krow = ML + b * CTXL + 128 * cc_; vtok = SEQ + 128 * cc_; } \
            else if (kind == 0) { const int kk_ = 64 * (lat0 + 2 * (cc_ - 2)); krow = b * SEQ + kk_; vtok = kk_; } \
            else { const int kk_ = lat0 + 128 * (cc_ - 2); krow = b * SEQ + kk_; vtok = kk_; } \
            K0 = *(const bf16x8*)(PA + (size_t)(krow + srow) * PAW + kcol + sc8); K1 = *(const bf16x8*)(PA + (size_t)(krow + 64 + srow) * PAW + kcol + sc8); \
            V0 = *(const bf16x8*)(vtb + (size_t)srow * VTOK + vtok + sc8); V1 = *(const bf16x8*)(vtb + (size_t)srow * VTOK + vtok + 64 + sc8); } while (0)
        bf16x8 ka0, ka1, va0, va1, kb0, kb1, vb0, vb1;
        CHUNK_LOAD(0, ka0, ka1, va0, va1); CHUNK_LOAD(1, kb0, kb1, vb0, vb1);
        auto chunk_compute = [&](const int c) __attribute__((always_inline)) {
            LAS bf16* Ks = Ks0 + (c & 1) * 128 * AS; LAS bf16* Vs = Vs0 + (c & 1) * 64 * VS;
            for (int pp = 0; pp < 2; ++pp) {
                int ko0, ko1, mode = 0; int x0[2] = {0, 0}, x1[2] = {0, 0};
                if (c < 2) { ko0 = 64 * pp; ko1 = ko0 + 32; }
                else if (kind == 0) { if (pp == 1) continue; const int kr = lat0 + 2 * (c - 2); bool any = false;
#pragma unroll
                    for (int t = 0; t < 2; ++t) { const bool v0 = kr >= rs[t] && kr < rs[t] + 8, v1 = kr + 1 >= rs[t] && kr + 1 < rs[t] + 8; any = any || v0 || v1; x0[t] = v0 ? kr - rr[t] + 7 : -1; x1[t] = v1 ? kr + 1 - rr[t] + 7 : -1; }
                    if (!any) continue; ko0 = cs; ko1 = 64 + cs; mode = 1; }
                else { const int kp = lat0 + 128 * (c - 2) + 64 * pp; if (kp + 63 < qlo[0] - 128 || kp > qlo[1] + 15 + 128) continue; ko0 = 64 * pp; ko1 = ko0 + 32; mode = 2; x0[0] = x0[1] = kp; x1[0] = x1[1] = kp + 32; }
                bf16x8 kfr[4][2];
#pragma unroll
                for (int mm = 0; mm < 4; ++mm) { const int ko = (mm < 2 ? ko0 : ko1) + kap + 4 * (mm & 1);
#pragma unroll
                    for (int ks = 0; ks < 2; ++ks) kfr[mm][ks] = *(const LAS bf16x8*)(Ks + ko * AS + ((32 * ks + 8 * g) ^ (((ko >> 4) & 1) << 5))); }
#pragma unroll
                for (int t = 0; t < 2; ++t) {
                    f32x4 cacc[4];
#pragma unroll
                    for (int mm = 0; mm < 4; ++mm) { cacc[mm] = (f32x4){0.f, 0.f, 0.f, 0.f};
#pragma unroll
                        for (int ks = 0; ks < 2; ++ks) cacc[mm] = __builtin_amdgcn_mfma_f32_16x16x32_bf16(kfr[mm][ks], qf[t][ks], cacc[mm], 0, 0, 0); }
                    float s[16];
#pragma unroll
                    for (int e = 0; e < 16; ++e) s[e] = cacc[e >> 2][e & 3];
                    if (mode == 1) {
                        float bv[16]; bool okv[16];
#pragma unroll
                        for (int hh = 0; hh < 2; ++hh) { const int xr = hh ? x1[t] : x0[t]; const LAS float* rp = rpbl + max(xr, 0) * 31 + 15 - qc;
#pragma unroll
                            for (int e = 0; e < 8; ++e) { const int kc = cs + 8 * g + e; const bool ok = xr >= 0 && kc >= c0 && kc < c0 + 16; okv[8 * hh + e] = ok; bv[8 * hh + e] = rp[min(max(kc, c0), c0 + 15)]; } }
#pragma unroll
                        for (int e = 0; e < 16; ++e) s[e] = okv[e] ? s[e] + bv[e] : -1e30f; }
                    else if (mode == 2) { const int qpos = qlo[t] + fr;
#pragma unroll
                        for (int hh = 0; hh < 2; ++hh) { const int kp = (hh ? x1[t] : x0[t]) + 8 * g;
#pragma unroll
                            for (int e = 0; e < 8; ++e) { const int d = qpos - (kp + e); s[8 * hh + e] = (d <= 128 && d >= -128) ? s[8 * hh + e] : -1e30f; } } }
                    float tm = s[0];
#pragma unroll
                    for (int e = 1; e < 16; ++e) tm = fmaxf(tm, s[e]);
                    tm = xmax32(xmax16(tm));
                    const float m_new = fmaxf(m_run[t], tm), alpha = __builtin_amdgcn_exp2f(m_run[t] - m_new);
                    float p[16], ps = 0.f;
#pragma unroll
                    for (int e = 0; e < 16; ++e) { p[e] = __builtin_amdgcn_exp2f(s[e] - m_new); ps += p[e]; }
                    l_run[t] = l_run[t] * alpha + ps; m_run[t] = m_new;
                    u32x4 pu0, pu1;
                    pu0.x = pg8::cvt_pk_bf16(p[0], p[1]); pu0.y = pg8::cvt_pk_bf16(p[2], p[3]); pu0.z = pg8::cvt_pk_bf16(p[4], p[5]); pu0.w = pg8::cvt_pk_bf16(p[6], p[7]);
                    pu1.x = pg8::cvt_pk_bf16(p[8], p[9]); pu1.y = pg8::cvt_pk_bf16(p[10], p[11]); pu1.z = pg8::cvt_pk_bf16(p[12], p[13]); pu1.w = pg8::cvt_pk_bf16(p[14], p[15]);
                    const bf16x8 pb0 = __builtin_bit_cast(bf16x8, pu0), pb1 = __builtin_bit_cast(bf16x8, pu1);
#pragma unroll
                    for (int dt = 0; dt < 4; ++dt) { acc[t][dt] = acc[t][dt] * alpha;
                        acc[t][dt] = __builtin_amdgcn_mfma_f32_16x16x32_bf16(*(const LAS bf16x8*)(Vs + (16 * dt + fr) * VS + ko0 + 8 * g), pb0, acc[t][dt], 0, 0, 0);
                        acc[t][dt] = __builtin_amdgcn_mfma_f32_16x16x32_bf16(*(const LAS bf16x8*)(Vs + (16 * dt + fr) * VS + ko1 + 8 * g), pb1, acc[t][dt], 0, 0, 0); }
                }
            }
        };
#define CHUNK_STEP(c_, K0, K1, V0, V1) do { const int cs_ = (c_); if (cs_ < nch) { \
            LAS bf16* kd_ = Ks0 + (cs_ & 1) * 128 * AS + srow * AS + (sc8 ^ (((srow >> 4) & 1) << 5)); LAS bf16* vd_ = Vs0 + (cs_ & 1) * 64 * VS + srow * VS + sc8; \
            *(LAS bf16x8*)kd_ = K0; *(LAS bf16x8*)(kd_ + 64 * AS) = K1; *(LAS bf16x8*)vd_ = V0; *(LAS bf16x8*)(vd_ + 64) = V1; \
            if (cs_ + 2 < nch) CHUNK_LOAD(cs_ + 2, K0, K1, V0, V1); \
            __syncthreads(); chunk_compute(cs_); } } while (0)
        for (int c = 0; c < nch; c += 2) { CHUNK_STEP(c, ka0, ka1, va0, va1); CHUNK_STEP(c + 1, kb0, kb1, vb0, vb1); }
#undef CHUNK_STEP
#undef CHUNK_LOAD
#pragma unroll
        for (int t = 0; t < 2; ++t) {
            const float lt = xsum32(xsum16(l_run[t])), inv = 1.0f / lt;
            bf16* op = O + (size_t)(qbase + qlo[t] + fr) * DM + ocol + 4 * g;
#pragma unroll
            for (int dt = 0; dt < 4; ++dt) { const f32x4 v = acc[t][dt] * inv; u32x2 w; w.x = pg8::cvt_pk_bf16(v[0], v[1]); w.y = pg8::cvt_pk_bf16(v[2], v[3]); *(u32x2*)(op + 16 * dt) = w; } }
    }
}

#define XB_TMO      128
#define XB_XCNT(j)  (256  + 64 * (j))
#define XB_XSUB(j)  (1280 + 64 * (j))
#define XB_XGEN(j)  (2304 + 64 * (j))
#define XB_TOP      3328
#define XB_TOPGEN   3392
#define XCD_BAR_WORDS 3456
#define XB_SPIN_CAP (1u << 18)

__device__ __forceinline__ unsigned xb_ld(unsigned* p)              { return __hip_atomic_load(p, __ATOMIC_RELAXED, __HIP_MEMORY_SCOPE_AGENT); }
__device__ __forceinline__ unsigned xb_add(unsigned* p, unsigned v) { return __hip_atomic_fetch_add(p, v, __ATOMIC_RELAXED, __HIP_MEMORY_SCOPE_AGENT); }
__device__ __forceinline__ unsigned xb_xcc_id() { return (unsigned)__builtin_amdgcn_s_getreg((3 << 11) | 20) & 0xFu; }
#define XB_SPIN(cond, bar) do { unsigned _sp = 0; while (cond) { __builtin_amdgcn_s_sleep(1); \
    if ((++_sp & 255u) == 0u) { if (xb_ld(&(bar)[XB_TMO])) break; if (_sp > XB_SPIN_CAP) { atomicAdd(&(bar)[XB_TMO], 1u); break; } } } } while (0)

struct XcdBarrier {
    unsigned* bar; unsigned x;
    volatile LAS unsigned* st;
};

__device__ __forceinline__ XcdBarrier xcd_barrier_post(unsigned* bar, volatile LAS unsigned* st) {
    XcdBarrier b; b.bar = bar; b.x = xb_xcc_id(); b.st = st;
    if (threadIdx.x == 0) (void)xb_add(&bar[XB_XCNT(b.x)], 1u);
    return b;
}
__device__ __forceinline__ void xcd_barrier_complete(unsigned* bar, unsigned x, unsigned& nloc, unsigned& nx) {
    const unsigned G = gridDim.x * gridDim.y * gridDim.z;
    unsigned sum, cnt, mine, sp = 0u;
    for (;;) {
        sum = 0u; cnt = 0u; mine = 0u;
#pragma unroll
        for (unsigned j = 0; j < 16; ++j) { const unsigned c = xb_ld(&bar[XB_XCNT(j)]); sum += c; cnt += (c > 0u) ? 1u : 0u; mine = (j == x) ? c : mine; }
        if (sum == G) break;
        __builtin_amdgcn_s_sleep(1);
        if ((++sp & 255u) == 0u) { if (xb_ld(&bar[XB_TMO])) break; if (sp > XB_SPIN_CAP) { atomicAdd(&bar[XB_TMO], 1u); break; } }
    }
    nloc = mine > 0u ? mine : 1u; nx = cnt > 0u ? cnt : 1u;
}

__device__ __forceinline__ void xcd_barrier(const XcdBarrier& b) {
    asm volatile("s_waitcnt vmcnt(0)" ::: "memory");
    __syncthreads();
    if (threadIdx.x == 0) {
        unsigned* bar = b.bar;
        __builtin_amdgcn_s_waitcnt(0);
        unsigned nloc = b.st[0], nx = b.st[1];
        if (nloc == 0u) { xcd_barrier_complete(bar, b.x, nloc, nx); b.st[0] = nloc; b.st[1] = nx; }
        const unsigned old = xb_add(&bar[XB_XSUB(b.x)], 1u);
        const unsigned gen = old / nloc;
        if (old + 1u == (gen + 1u) * nloc) {
            __builtin_amdgcn_fence(__ATOMIC_RELEASE, "agent");
            asm volatile("s_waitcnt vmcnt(0)" ::: "memory");
            const unsigned og = xb_add(&bar[XB_TOP], 1u);
            const unsigned tg = og / nx;
            if (og + 1u == (tg + 1u) * nx) xb_add(&bar[XB_TOPGEN], 1u);
            else XB_SPIN(xb_ld(&bar[XB_TOPGEN]) == tg, bar);
            __builtin_amdgcn_fence(__ATOMIC_ACQUIRE, "agent");
            xb_add(&bar[XB_XGEN(b.x)], 1u);
            asm volatile("s_waitcnt vmcnt(0)" ::: "memory");
        } else {
            XB_SPIN(xb_ld(&bar[XB_XGEN(b.x)]) == gen, bar);
            __builtin_amdgcn_fence(__ATOMIC_ACQUIRE, "agent");
            asm volatile("s_waitcnt vmcnt(0)" ::: "memory");
        }
    }
    __syncthreads();
}

__global__ void __launch_bounds__(512, 2) mk_fwd(Args a_unused) {
    extern __shared__ __attribute__((aligned(16))) unsigned char lds_raw[];
    LAS unsigned char* L = (LAS unsigned char*)lds_raw;
    cg::grid_group grid = cg::this_grid();
    volatile LAS unsigned* bst = (volatile LAS unsigned*)(L + LDS_BYTES - 64);
    if (threadIdx.x < 2) bst[threadIdx.x] = 0u;
    __syncthreads();
    ArgsP a0 = (ArgsP)__builtin_amdgcn_kernarg_segment_ptr();
    const int ph_hi = a0->ph_hi;
    XcdBarrier xbar = xcd_barrier_post((unsigned*)(a0->ws + WS_BAR), bst);
    for (int ph = a0->ph_lo; ph < ph_hi; ++ph) {
        ArgsP a = a0; asm volatile("" : "+s"(a) :: "memory");
        int tid = threadIdx.x; asm volatile("" : "+v"(tid));
        const int lane = tid & 63, wave = __builtin_amdgcn_readfirstlane(tid >> 6);
#ifndef PMASK
#define PMASK 0xFFFF
#endif
        if ((PMASK & 1) && ph == 0) phase_prologue(a, L, tid, lane, wave);
        else if ((PMASK & 2) && ph == NPHASE - 1) phase_final(a, lane, wave);
        else {
            const int l = (ph - 1) / 12, k = (ph - 1) % 12;
            const bool need_ctx = l < DEPTH - 1;
            if ((PMASK & 4) && (k == 0 || k == 3 || k == 9)) { const int sub = k == 0 ? 0 : k == 3 ? 1 : 2; const int nsp = sub == 1 ? 6 : sub == 2 ? (need_ctx ? 4 : 0) : (l > 0 ? 6 : 0); phase_norm(a, l, sub, (sub == 2 && !need_ctx) ? ML : MT, nsp, lane, wave); }
            else if ((PMASK & 8) && (k == 1 || k == 10 || k == 2 || k == 8 || k == 11 || k == 4)) {
                unsigned char* ws = a->ws; asm volatile("" : "+s"(ws) :: "memory");
                const bf16* A; const bf16* Bt; int Mr = MT, N, K; EpiAll E{ws, 0, l, 0, 0.5f, 0, 1}; int ntsplit = 0;
                if (k == 1 || k == 10) { const int s = k == 1 ? 0 : 1; if (s == 1 && !need_ctx) Mr = ML; A = (const bf16*)(ws + WS_XN); Bt = w13p(ws, l, s); N = 2 * FF; K = DM; E.mode = 0; }
                else if (k == 4) { A = (const bf16*)(ws + WS_XN); Bt = winp(ws, l); N = INW; K = DM; E.mode = 2; }
                else { E.mode = 1; N = DM; if (k != 2 && !need_ctx) Mr = ML;
                    ntsplit = (k == 8) ? 4 : 8;
                    if (k == 2) { A = (const bf16*)(ws + WS_U); Bt = w2p(ws, l, 0); K = FF; E.gi = 2; }
                    else if (k == 8) { A = (const bf16*)(ws + WS_O); Bt = woutp(ws, l); K = DM; E.coef = 1.0f; E.gi = 5; }
                    else { A = (const bf16*)(ws + WS_U); Bt = w2p(ws, l, 1); K = FF; E.gi = 8; } }
                E.ntfull = K / 64; E.ntsplit = ntsplit > 0 ? ntsplit : 1;
                pg8::Gemm gm{A, Bt, Mr, N, K}; pg8::StaticOrder S; S.init(Mr, N, K, gridDim.x, blockIdx.x, ntsplit);
                pg8::gemm_phase<EpiAll, pg8::StaticOrder, true, true>(L, gm, S, E); }
            else if ((PMASK & 64) && k == 5) phase_h1(a, L, tid, lane, wave);
            else if ((PMASK & 128) && k == 6) phase_h2(a, tid);
            else if (k == 7) { if (PMASK & 256) phase_h3(a, L, l, need_ctx, tid, lane, wave); if (PMASK & 512) phase_attn(a, L, l, need_ctx, tid, lane, wave); }
        }
        if (ph + 1 < ph_hi) { if (ph == 0) grid.sync(); else xcd_barrier(xbar); }
    }
}

extern "C" void kernel_launch(void* const* d_in, const int* in_sizes, int n_in, void* d_out, int out_size, void* d_ws, size_t ws_size, hipStream_t stream) {
    static int grid = 0;
    if (grid == 0) {
        if (n_in != 17 || out_size != ML * DM || ws_size < WS_END) { fprintf(stderr, "kernel_launch: unexpected shapes (n_in %d out %d ws %zu need %zu)\n", n_in, out_size, ws_size, (size_t)WS_END); grid = -1; return; }
        int dev = 0, cus = 0, per_cu = 0;
        hipGetDevice(&dev); hipDeviceGetAttribute(&cus, hipDeviceAttributeMultiprocessorCount, dev);
        if (hipFuncSetAttribute((const void*)mk_fwd, hipFuncAttributeMaxDynamicSharedMemorySize, LDS_BYTES) != hipSuccess) { fprintf(stderr, "kernel_launch: hipFuncSetAttribute failed\n"); grid = -1; return; }
        if (hipOccupancyMaxActiveBlocksPerMultiprocessor(&per_cu, (const void*)mk_fwd, 512, LDS_BYTES) != hipSuccess || per_cu < 1) { fprintf(stderr, "kernel_launch: occupancy query says %d\n", per_cu); per_cu = 1; }
        (void)hipGetLastError();
        grid = cus * per_cu;
        fprintf(stderr, "kernel_launch: grid %d (cus %d x %d)\n", grid, cus, per_cu);
    }
    if (grid < 0) return;
    Args a{};
    a.x = (const float*)d_in[0]; a.c = (const float*)d_in[1]; a.ctx = (const float*)d_in[2]; a.c_ctx = (const float*)d_in[3]; a.ada_w = (const float*)d_in[4]; a.ada_b = (const float*)d_in[5];
    a.norm_g = (const float*)d_in[6]; a.w1 = (const float*)d_in[7]; a.w3 = (const float*)d_in[8]; a.w2 = (const float*)d_in[9]; a.w_in = (const float*)d_in[10]; a.w_out = (const float*)d_in[11];
    a.lb_logits = (const float*)d_in[12]; a.hg_norm_g = (const float*)d_in[13]; a.rpb = (const float*)d_in[14]; a.sink = (const float*)d_in[15]; a.final_g = (const float*)d_in[16];
    a.out = (float*)d_out; a.ws = (unsigned char*)d_ws;
#if ONE_LAUNCH
    if (hipMemsetAsync((unsigned char*)d_ws + WS_BAR, 0, BAR_BYTES, stream) != hipSuccess) { fprintf(stderr, "kernel_launch: memset failed\n"); return; }
    a.ph_lo = 0; a.ph_hi = NPHASE;
    void* args[] = {&a};
    hipError_t e = hipLaunchCooperativeKernel((const void*)mk_fwd, dim3(grid), dim3(512), args, LDS_BYTES, stream);
    if (e != hipSuccess) fprintf(stderr, "cooperative launch failed: %s (grid %d)\n", hipGetErrorString(e), grid);
#else
    for (int ph = 0; ph < NPHASE; ++ph) { a.ph_lo = ph; a.ph_hi = ph + 1; hipLaunchKernelGGL(mk_fwd, dim3(grid), dim3(512), LDS_BYTES, stream, a); }
#endif
}
```
